# Optimizing an MI355X kernel written in HIP

```python
import jax, jax.numpy as jnp
from jax import lax
import numpy as np

D_MODEL = 2048
BATCH = 4
SEQ = 4096
DEPTH = 2

CTX_LEN = 256
GRID_W = 64
N_MIXERS = 2
NORM_EPS = 1e-6
N_MOD = 6

MLSTM_HEADS = 8
MLSTM_QK_DIM = D_MODEL // 2 // MLSTM_HEADS
MLSTM_V_DIM = D_MODEL // MLSTM_HEADS
MLSTM_CHUNK = 64
GATE_SOFTCAP = 15.0
MLSTM_IN_COLS = 2 * MLSTM_HEADS * MLSTM_QK_DIM + 2 * MLSTM_HEADS * MLSTM_V_DIM + 4 * MLSTM_HEADS

ATTN_HEAD_DIM = 128
ATTN_Q_HEADS = D_MODEL // ATTN_HEAD_DIM
ATTN_KV_HEADS = 4
ATTN_QKV_COLS = (ATTN_Q_HEADS + 2 * ATTN_KV_HEADS) * ATTN_HEAD_DIM
Q_BLOCK = 128
ROPE_THETA = 10000.0

FFN_HIDDEN = -(-8 * D_MODEL // (3 * 256)) * 256

kernel_name = "hybrid_mlstm_gqa_prefix_dit"


def rms_norm(x, w):
    xf = x.astype(jnp.float32)
    y = xf * lax.rsqrt(jnp.mean(xf * xf, axis=-1, keepdims=True) + NORM_EPS)
    return (y * w.astype(jnp.float32)).astype(x.dtype)


def adaln(x, g, shift, scale):
    return rms_norm(x, g) * (1 + scale) + shift


def swiglu(h, w_in, w_out):
    gate, up = jnp.split(h @ w_in, 2, axis=-1)
    return (jax.nn.silu(gate) * up) @ w_out


def softcap(a, cap):
    return cap * jnp.tanh(a / cap)


def mlstm_project(h, w_in, b_gate):
    H, dk, dv = MLSTM_HEADS, MLSTM_QK_DIM, MLSTM_V_DIM
    p = h @ w_in
    B, T, _ = p.shape
    q, k, v, o, g = jnp.split(p, [H * dk, 2 * H * dk, 2 * H * dk + H * dv, 2 * H * dk + 2 * H * dv], axis=-1)
    q = q.reshape(B, T, H, dk).transpose(0, 2, 1, 3) * (dk ** -0.5)
    k = k.reshape(B, T, H, dk).transpose(0, 2, 1, 3)
    v = v.reshape(B, T, H, dv).transpose(0, 2, 1, 3)
    g = softcap(g.astype(jnp.float32) + b_gate.astype(jnp.float32), GATE_SOFTCAP)
    g = g.reshape(B, T, 4, H).transpose(2, 0, 3, 1)
    return q, k, v, o, g[0], jax.nn.log_sigmoid(g[1]), g[2], jax.nn.log_sigmoid(g[3])


def mlstm_scan(q, k, v, ig, lf, state):
    B, H, T, dk = q.shape
    dv = v.shape[-1]
    L = MLSTM_CHUNK
    nc = T // L

    def chunks(a):
        a = a.astype(jnp.float32).reshape(B, H, nc, L, *a.shape[3:])
        return jnp.moveaxis(a, 2, 0)

    lower = jnp.tril(jnp.ones((L, L), dtype=bool))

    def body(carry, inp):
        C, n, m = carry
        qc, kc, vc, ic, fc = inp
        b = jnp.cumsum(fc, axis=-1)
        log_d = b[..., :, None] - b[..., None, :] + ic[..., None, :]
        log_d = jnp.where(lower, log_d, -jnp.inf)
        log_inter = b + m[..., None]
        m_t = jnp.maximum(log_inter, jnp.max(log_d, axis=-1))
        dmat = jnp.exp(log_d - m_t[..., None])
        inter = jnp.exp(log_inter - m_t)
        sm = jnp.einsum('bhtd,bhsd->bhts', qc, kc) * dmat
        num = jnp.einsum('bhts,bhsv->bhtv', sm, vc) + inter[..., None] * jnp.einsum('bhtd,bhdv->bhtv', qc, C)
        den = jnp.sum(sm, axis=-1) + inter * jnp.einsum('bhtd,bhd->bht', qc, n)
        h = num / jnp.maximum(jnp.abs(den), jnp.exp(-m_t))[..., None]
        b_end = b[..., -1]
        log_w = b_end[..., None] - b + ic
        m_new = jnp.maximum(b_end + m, jnp.max(log_w, axis=-1))
        w = jnp.exp(log_w - m_new[..., None])
        decay = jnp.exp(b_end + m - m_new)
        C_new = decay[..., None, None] * C + jnp.einsum('bhs,bhsd,bhsv->bhdv', w, kc, vc)
        n_new = decay[..., None] * n + jnp.einsum('bhs,bhsd->bhd', w, kc)
        return (C_new, n_new, m_new), h

    state, hs = lax.scan(body, state, (chunks(q), chunks(k), chunks(v), chunks(ig), chunks(lf)))
    h = jnp.moveaxis(hs, 0, 2).reshape(B, H, T, dv)
    return state, h


def mlstm_out(h, o, g_head, w_out):
    B, H, T, dv = h.shape
    hn = h * lax.rsqrt(jnp.mean(h * h, axis=-1, keepdims=True) + NORM_EPS)
    hn = hn * g_head.astype(jnp.float32).reshape(1, H, 1, dv)
    hn = hn.transpose(0, 2, 1, 3).reshape(B, T, H * dv).astype(o.dtype)
    return (jax.nn.sigmoid(o) * hn) @ w_out


def mlstm_mixer(h_lat, h_ctx, w_in, b_gate, g_head, w_out, with_ctx_out):
    ql, kl, vl, ol, il_f, fl_f, il_b, fl_b = mlstm_project(h_lat, w_in, b_gate)
    qc, kc, vc, oc, ic_f, fc_f, ic_b, fc_b = mlstm_project(h_ctx, w_in, b_gate)
    B = h_lat.shape[0]
    H, dk, dv = MLSTM_HEADS, MLSTM_QK_DIM, MLSTM_V_DIM
    zero = (jnp.zeros((B, H, dk, dv), jnp.float32), jnp.zeros((B, H, dk), jnp.float32),
            jnp.zeros((B, H), jnp.float32))
    rev = lambda a: jnp.flip(a, axis=2)
    st_f, hc_f = mlstm_scan(qc, kc, vc, ic_f, fc_f, zero)
    st_b, hc_b = mlstm_scan(rev(qc), rev(kc), rev(vc), rev(ic_b), rev(fc_b), zero)
    _, hl_f = mlstm_scan(ql, kl, vl, il_f, fl_f, st_f)
    _, hl_b = mlstm_scan(rev(ql), rev(kl), rev(vl), rev(il_b), rev(fl_b), st_b)
    y_lat = mlstm_out(hl_f + rev(hl_b), ol, g_head, w_out)
    y_ctx = mlstm_out(hc_f + rev(hc_b), oc, g_head, w_out) if with_ctx_out else None
    return y_lat, y_ctx


def axial_rope_tables(n_tokens):
    rows = n_tokens // GRID_W
    t_row = jnp.repeat(jnp.arange(rows, dtype=jnp.float32), GRID_W)
    t_col = jnp.tile(jnp.arange(GRID_W, dtype=jnp.float32), rows)
    per_axis = ATTN_HEAD_DIM // 2
    inv = ROPE_THETA ** (-jnp.arange(0, per_axis, 2, dtype=jnp.float32) / per_axis)
    ang = jnp.concatenate([t_row[:, None] * inv, t_col[:, None] * inv], axis=-1)
    return jnp.cos(ang), jnp.sin(ang)


def apply_rope(x, cos, sin):
    xp = x.astype(jnp.float32).reshape(*x.shape[:-1], x.shape[-1] // 2, 2)
    x0, x1 = xp[..., 0], xp[..., 1]
    c = cos[None, :, None, :]
    s = sin[None, :, None, :]
    out = jnp.stack([x0 * c - x1 * s, x0 * s + x1 * c], axis=-1)
    return out.reshape(x.shape).astype(x.dtype)


def gqa_attend(q, k, v):
    s = jnp.einsum('bqkgd,bskd->bkgqs', q, k) * (ATTN_HEAD_DIM ** -0.5)
    p = jax.nn.softmax(s.astype(jnp.float32), axis=-1).astype(v.dtype)
    return jnp.einsum('bkgqs,bskd->bqkgd', p, v)


def attn_mixer(h_lat, h_ctx, w_qkv, g_q, g_k, w_out, with_ctx_out):
    Hq, Hkv, dh = ATTN_Q_HEADS, ATTN_KV_HEADS, ATTN_HEAD_DIM
    G = Hq // Hkv

    def qkv(h):
        p = h @ w_qkv
        B, T, _ = p.shape
        q, k, v = jnp.split(p, [Hq * dh, (Hq + Hkv) * dh], axis=-1)
        q = rms_norm(q.reshape(B, T, Hq, dh), g_q)
        k = rms_norm(k.reshape(B, T, Hkv, dh), g_k)
        return q, k, v.reshape(B, T, Hkv, dh)

    ql, kl, vl = qkv(h_lat)
    qc, kc, vc = qkv(h_ctx)
    B, T = h_lat.shape[:2]
    Lc = h_ctx.shape[1]
    cos, sin = axial_rope_tables(T)
    ql = apply_rope(ql, cos, sin)
    kl = apply_rope(kl, cos, sin)
    k_all = jnp.concatenate([kl, kc], axis=1)
    v_all = jnp.concatenate([vl, vc], axis=1)
    nb = T // Q_BLOCK
    qb = ql.reshape(B, nb, Q_BLOCK, Hkv, G, dh).transpose(1, 0, 2, 3, 4, 5)
    o_lat = lax.map(lambda qblk: gqa_attend(qblk, k_all, v_all), qb)
    o_lat = o_lat.transpose(1, 0, 2, 3, 4, 5).reshape(B, T, Hq * dh)
    y_lat = o_lat @ w_out
    if with_ctx_out:
        o_ctx = gqa_attend(qc.reshape(B, Lc, Hkv, G, dh), kc, vc).reshape(B, Lc, Hq * dh)
        y_ctx = o_ctx @ w_out
    else:
        y_ctx = None
    return y_lat, y_ctx


def setup_inputs(seed: int = 0) -> dict:
    key = jax.random.key(seed)
    ks = jax.random.split(key, 24)
    f32 = jnp.float32
    D, F = D_MODEL, FFN_HIDDEN
    n_a = (DEPTH + N_MIXERS - 1) // N_MIXERS
    n_b = DEPTH // N_MIXERS
    H = MLSTM_HEADS
    nrm = lambda k, shape, scale: jax.random.normal(k, shape, f32) * scale
    gain = lambda k, shape: 1.0 + 0.05 * jax.random.normal(k, shape, f32)
    fg_bias = jnp.linspace(3.0, 6.0, H, dtype=f32)
    gate_off = jnp.stack([jnp.zeros((H,), f32), fg_bias, jnp.zeros((H,), f32), fg_bias])
    b_gate = (0.1 * jax.random.normal(ks[10], (n_a, 4, H), f32) + gate_off).reshape(n_a, 4 * H)
    return {
        "x": jax.random.normal(ks[0], (BATCH, SEQ, D), f32),
        "c": jax.random.normal(ks[1], (BATCH, D), f32),
        "ctx": jax.random.normal(ks[2], (BATCH, CTX_LEN, D), f32),
        "c_ctx": jax.random.normal(ks[3], (D,), f32),
        "w_mod": nrm(ks[4], (DEPTH, D, N_MOD * D), 0.5 * D ** -0.5),
        "b_mod": nrm(ks[5], (DEPTH, N_MOD * D), 0.02),
        "g_mix_pre": gain(ks[6], (DEPTH, D)),
        "g_mix_post": gain(ks[7], (DEPTH, D)),
        "g_ffn_pre": gain(ks[8], (DEPTH, D)),
        "g_ffn_post": gain(ks[9], (DEPTH, D)),
        "w_mlstm_in": nrm(ks[11], (n_a, D, MLSTM_IN_COLS), D ** -0.5),
        "b_mlstm_gate": b_gate,
        "g_mlstm_head": gain(ks[12], (n_a, H * MLSTM_V_DIM)),
        "w_mlstm_out": nrm(ks[13], (n_a, H * MLSTM_V_DIM, D), (H * MLSTM_V_DIM) ** -0.5),
        "w_attn_qkv": nrm(ks[14], (n_b, D, ATTN_QKV_COLS), D ** -0.5),
        "g_attn_q": gain(ks[15], (n_b, ATTN_HEAD_DIM)),
        "g_attn_k": gain(ks[16], (n_b, ATTN_HEAD_DIM)),
        "w_attn_out": nrm(ks[17], (n_b, ATTN_Q_HEADS * ATTN_HEAD_DIM, D), (ATTN_Q_HEADS * ATTN_HEAD_DIM) ** -0.5),
        "w_ffn_in": nrm(ks[18], (DEPTH, D, 2 * F), D ** -0.5),
        "w_ffn_out": nrm(ks[19], (DEPTH, F, D), F ** -0.5),
    }


def reference(x, c, ctx, c_ctx, w_mod, b_mod, g_mix_pre, g_mix_post, g_ffn_pre, g_ffn_post,
              w_mlstm_in, b_mlstm_gate, g_mlstm_head, w_mlstm_out,
              w_attn_qkv, g_attn_q, g_attn_k, w_attn_out, w_ffn_in, w_ffn_out):
    cond_lat = jax.nn.silu(c)
    cond_ctx = jax.nn.silu(c_ctx)
    for i in range(DEPTH):
        last = i == DEPTH - 1
        j = i // N_MIXERS
        sh1, sc1, gt1, sh2, sc2, gt2 = jnp.split((cond_lat @ w_mod[i] + b_mod[i])[:, None, :], N_MOD, axis=-1)
        csh1, csc1, cgt1, csh2, csc2, cgt2 = jnp.split(cond_ctx @ w_mod[i] + b_mod[i], N_MOD, axis=-1)
        h_lat = adaln(x, g_mix_pre[i], sh1, sc1)
        h_ctx = adaln(ctx, g_mix_pre[i], csh1, csc1)
        if i % N_MIXERS == 0:
            y_lat, y_ctx = mlstm_mixer(h_lat, h_ctx, w_mlstm_in[j], b_mlstm_gate[j], g_mlstm_head[j],
                                       w_mlstm_out[j], not last)
        else:
            y_lat, y_ctx = attn_mixer(h_lat, h_ctx, w_attn_qkv[j], g_attn_q[j], g_attn_k[j],
                                      w_attn_out[j], not last)
        x = x + gt1 * rms_norm(y_lat, g_mix_post[i])
        f_lat = swiglu(adaln(x, g_ffn_pre[i], sh2, sc2), w_ffn_in[i], w_ffn_out[i])
        x = x + gt2 * rms_norm(f_lat, g_ffn_post[i])
        if not last:
            ctx = ctx + cgt1 * rms_norm(y_ctx, g_mix_post[i])
            f_ctx = swiglu(adaln(ctx, g_ffn_pre[i], csh2, csc2), w_ffn_in[i], w_ffn_out[i])
            ctx = ctx + cgt2 * rms_norm(f_ctx, g_ffn_post[i])
    return x
```

```cpp
#include <hip/hip_runtime.h>
#include <cstdio>
#include <cstdint>

constexpr int BATCH = 4, SEQ = 4096, CTXL = 256, DM = 2048;
constexpr int RB = SEQ + CTXL;
constexpr int R = BATCH * RB;
constexpr int NMOD = 6 * DM;
constexpr int MH = 8, MDK = 128, MDV = 256, MIN_COLS = 6176, MIN_PAD = 6400;
constexpr int FF = 5632;
constexpr int AHQ = 16, AHKV = 4, ADH = 128, QKV_COLS = 3072;
constexpr float NORM_EPS = 1e-6f;
constexpr int NWAVES = 8, NTHREADS = 512;

constexpr int LDA2 = DM + 64;
constexpr int LDF = FF + 64;
constexpr int LDW = DM + 64, LDWF = FF + 64;
constexpr int PRJ_LD = 6144 + 64;
constexpr int LDKV = 512 + 64;

constexpr size_t MiB = 1u << 20;
constexpr size_t WS_CTL = 0, CTL_ZERO_BYTES = 64 * 1024;
constexpr size_t WS_MOD = 1 * MiB;
constexpr size_t WS_WIN = 2 * MiB;
constexpr size_t WS_WMO = WS_WIN + (size_t)MIN_PAD * LDW * 2;
constexpr size_t WS_WQKV = WS_WMO + (size_t)DM * LDW * 2;
constexpr size_t WS_WAO = WS_WQKV + (size_t)QKV_COLS * LDW * 2;
constexpr size_t WS_WFI = WS_WAO + (size_t)DM * LDW * 2;
constexpr size_t WS_WFO = WS_WFI + (size_t)2 * 2 * FF * LDW * 2;
constexpr size_t WS_WEND = WS_WFO + (size_t)2 * DM * LDWF * 2;
constexpr size_t WS_X = 192 * MiB;
constexpr size_t WS_HA = 260 * MiB;
constexpr size_t WS_PRJ = 331 * MiB;
constexpr size_t WS_HF = 538 * MiB;
constexpr size_t WS_HB = 609 * MiB;
constexpr size_t WS_GATES = 680 * MiB;
constexpr size_t WS_YS = 683 * MiB;
constexpr size_t WS_QS = 700 * MiB;
constexpr size_t WS_ROPE = 716 * MiB;
constexpr size_t WS_END = 717 * MiB;
static_assert(WS_WEND <= WS_X, "weights fit");
static_assert(WS_X + (size_t)R * DM * 2 <= WS_HA && WS_HA + (size_t)R * LDA2 * 2 <= WS_PRJ && WS_PRJ + (size_t)R * PRJ_LD * 2 <= WS_HF && WS_HF + (size_t)R * LDA2 * 2 <= WS_HB && WS_HB + (size_t)R * LDA2 * 2 <= WS_GATES, "activation map");
static_assert(WS_GATES + (size_t)R * 32 * 4 <= WS_YS && WS_YS + (size_t)4 * 1024 * LDA2 * 2 <= WS_QS && WS_QS + (size_t)8 * 1024 * 1024 * 2 <= WS_END, "slab map");
constexpr size_t WS_Q1 = WS_PRJ, WS_K1 = WS_Q1 + (size_t)R * LDA2 * 2, WS_V1 = WS_K1 + (size_t)R * LDKV * 2;
static_assert(WS_V1 + (size_t)R * LDKV * 2 <= WS_HF && WS_PRJ + (size_t)R * LDF * 2 <= WS_HF, "qkv1 / H fit");
constexpr size_t WS_Y = WS_HF;
constexpr int CW_BAR = 4096;

constexpr int LDS_BYTES = 147456;
constexpr int MISC_OFF = LDS_BYTES - 512;

#define GAS __attribute__((address_space(1)))
#define LAS __attribute__((address_space(3)))
typedef unsigned short bf16_t;
typedef unsigned v4u __attribute__((ext_vector_type(4)));
typedef unsigned v2u __attribute__((ext_vector_type(2)));
typedef float f32x4 __attribute__((ext_vector_type(4)));
#define LDS_WAIT() asm volatile("s_waitcnt lgkmcnt(0)" ::: "memory")
#define VM_WAIT() asm volatile("s_waitcnt vmcnt(0)" ::: "memory")
__device__ __forceinline__ unsigned f2bf(float f) { unsigned u = __builtin_bit_cast(unsigned, f); return (u + 0x7fffu + ((u >> 16) & 1u)) >> 16; }
__device__ __forceinline__ unsigned pk2(float lo, float hi) { return f2bf(lo) | (f2bf(hi) << 16); }
__device__ __forceinline__ float bf2f(unsigned short b) { return __builtin_bit_cast(float, (unsigned)b << 16); }
__device__ __forceinline__ float bflo(unsigned w) { return __builtin_bit_cast(float, w << 16); }
__device__ __forceinline__ float bfhi(unsigned w) { return __builtin_bit_cast(float, w & 0xffff0000u); }
template <int CTRL> __device__ __forceinline__ float dpp_f(float v) { return __builtin_bit_cast(float, __builtin_amdgcn_update_dpp(0, __builtin_bit_cast(int, v), CTRL, 0xf, 0xf, false)); }
__device__ __forceinline__ float row_sum16(float v) { v += dpp_f<0xB1>(v); v += dpp_f<0x4E>(v); v += dpp_f<0x141>(v); v += dpp_f<0x140>(v); return v; }
__device__ __forceinline__ float rl_f(float v, int l) { return __builtin_bit_cast(float, __builtin_amdgcn_readlane(__builtin_bit_cast(int, v), l)); }
__device__ __forceinline__ float wave_sum(float v) { v = row_sum16(v); return (rl_f(v, 0) + rl_f(v, 16)) + (rl_f(v, 32) + rl_f(v, 48)); }
__device__ __forceinline__ float rcp_f(float v) { return __builtin_amdgcn_rcpf(v); }
__device__ __forceinline__ float rsq_f(float v) { return __builtin_amdgcn_rsqf(v); }
__device__ __forceinline__ float silu_f(float v) { return v / (1.0f + __expf(-v)); }
__device__ __forceinline__ float sigmoid_f(float v) { return 1.0f / (1.0f + __expf(-v)); }
typedef float sf32x2_t __attribute__((ext_vector_type(2))); typedef __bf16 sbf16x2_t __attribute__((ext_vector_type(2)));
__device__ __forceinline__ unsigned cvtpk2(float lo, float hi) { sf32x2_t v = {lo, hi}; sbf16x2_t b = __builtin_convertvector(v, sbf16x2_t); return __builtin_bit_cast(unsigned, b); }
namespace pg8 {
#define PG8_LAS __attribute__((address_space(3)))
typedef unsigned short bf16_t;
typedef short bf16x8 __attribute__((ext_vector_type(8)));
typedef float f32x4 __attribute__((ext_vector_type(4)));
typedef unsigned u32x4 __attribute__((ext_vector_type(4)));
constexpr int BM = 256, BK = 64, HALF = 128, HTB = HALF * BK * 2  , STAGE_BYTES = 8 * HTB, NXCD = 8, WGM = 8;

__host__ __device__ __forceinline__ int lds_byte(int r, int c) { const int st = (r >> 4) * 2 + (c >> 5), rr = r & 15, cc = c & 31, ob = rr * 64 + cc * 2; return st * 1024 + (ob ^ (((ob >> 9) & 1) << 5)); }
__host__ __device__ __forceinline__ void stage_rc(int b, int& R, int& C) { const int st = b / 1024, sb = b % 1024, swz = sb ^ (((sb >> 9) & 1) << 5); R = (st >> 1) * 16 + swz / 64; C = (st & 1) * 32 + (swz % 64) / 2; }
__host__ __device__ __forceinline__ int perm32(int rho) { const int n = rho >> 4, i = rho & 15; return 8 * (i >> 2) + 4 * n + (i & 3); }

struct Unit { int pm, pn, kt0, nt, slab; };
struct Gemm { const bf16_t* A; const bf16_t* Bt; int M, N, K, lda, ldb; };

__device__ __forceinline__ unsigned cvt_pk_bf16(float lo, float hi) { unsigned r; asm volatile("s_nop 1\n\tv_cvt_pk_bf16_f32 %0, %1, %2" : "=v"(r) : "v"(lo), "v"(hi)); return r; }
typedef float f32x2 __attribute__((ext_vector_type(2)));
struct Order {
    int nM, nN, nwg, G, c, latonly, ntk;
    int same = 0, allsplit = 0;
    int nsub, cpn0, cnN;
    int pn24 = 0;
    __device__ void init(int nM_, int nN_, int G_, int c_, int latonly_, int ntk_) { nM = nM_; nN = nN_; nwg = nM * nN; G = G_; c = c_; latonly = latonly_; ntk = ntk_; nsub = 0; cpn0 = 0; cnN = 0; }
    __device__ void ctx_split(int nsub_, int cpn0_, int cnN_) { nsub = nsub_; cpn0 = cpn0_; cnN = cnN_; }
    __device__ __forceinline__ bool next(int i, Unit& u) const {
        long L = (long)i * G + c; int aks = 0;
        if (allsplit) { if (L >= (long)nwg * allsplit) return false; aks = (int)(L % allsplit); L /= allsplit; }
        const bool sub = L >= nwg;
        const int nctx = nsub ? 4 * cnN * nsub : 0;
        const int e = sub ? (int)(L - nwg) : 0;
        const bool ok = sub ? (e < nctx) : true;
        const int ns = nsub ? nsub : 1, cn = cnN ? cnN : 1;
        const int ks = e % ns, r = e / ns;
        int wgid = sub ? 0 : (int)L; { const int q = nwg / NXCD, rr = nwg % NXCD, xcd = wgid % NXCD, off = wgid / NXCD; wgid = (xcd < rr ? xcd * (q + 1) : rr * (q + 1) + (xcd - rr) * q) + off; }
        const int nig = WGM * nN, gid = wgid / nig, fm = gid * WGM, gsz = (nM - fm) < WGM ? (nM - fm) : WGM;
        const int pm0 = fm + ((wgid % nig) % gsz), pn0 = (wgid % nig) / gsz;
        const int pm1 = latonly ? pm0 + (pm0 >> 4) : pm0;
        const int snt = ntk / ns;
        u.pm = same ? 0 : (sub ? 17 * (r / cn) + 16 : pm1);
        u.pn = same ? 0 : (sub ? cpn0 + r % cn : ((pn24 && pn0 == 16) ? 24 : pn0));
        u.nt = sub ? snt : (allsplit ? ntk / allsplit : ntk);
        u.kt0 = sub ? ks * snt : (allsplit ? aks * (ntk / allsplit) : 0);
        u.slab = sub ? ks : -1;
        return ok;
    }
    __device__ __forceinline__ void a_ready(const Unit&) const {}
    __device__ __forceinline__ void done(const Unit&) const {}
};

__device__ __forceinline__ u32x4 pack8(const f32x4 v0, const f32x4 v1) { u32x4 w; w.x = cvt_pk_bf16(v0[0], v0[1]); w.y = cvt_pk_bf16(v0[2], v0[3]); w.z = cvt_pk_bf16(v1[0], v1[1]); w.w = cvt_pk_bf16(v1[2], v1[3]); return w; }

struct EpiPlain {
    static constexpr bool PERM = true, AFTER_DRAIN = false;
    bf16_t* O; int ldc; bf16_t* OS;
    __device__ __forceinline__ void operator()(const f32x4 (&acc)[2][2][4][2], const Unit& u, int wr, int wc, int fr, int fq) const {
        const int col0 = u.pn * BM + wc * 32 + 8 * fq; int row0 = u.pm * BM + wr * 64 + fr; bf16_t* base = O;
        if (u.slab >= 0) { row0 = (u.slab * 4 + u.pm / 17) * BM + wr * 64 + fr; base = OS; }
#pragma unroll
        for (int ai = 0; ai < 2; ++ai)
#pragma unroll
            for (int m = 0; m < 4; ++m) { bf16_t* rowp = base + (size_t)(row0 + ai * HALF + m * 16) * ldc + col0;
#pragma unroll
                for (int bj = 0; bj < 2; ++bj) *(u32x4*)(rowp + bj * HALF) = pack8(acc[ai][bj][m][0], acc[ai][bj][m][1]); }
    }
};
struct EpiQkv {
    static constexpr bool PERM = true, AFTER_DRAIN = false;
    bf16_t* Q; bf16_t* K; bf16_t* V; bf16_t* QS;
    const float* gq; const float* gk; const float* rope;
    PG8_LAS float* xt;
    __device__ __forceinline__ void operator()(const f32x4 (&acc)[2][2][4][2], const Unit& u, int wr, int wc, int fr, int fq) const {
        int row0 = u.pm * BM + wr * 64 + fr; bf16_t* base; int ldc, colt;
        if (u.slab >= 0) { base = QS; ldc = 1024; colt = (u.pn - 8) * BM; row0 = (u.slab * 4 + u.pm / 17) * BM + wr * 64 + fr; }
        else if (u.pn < 8) { base = Q; ldc = 2112; colt = u.pn * BM; } else if (u.pn < 10) { base = K; ldc = 576; colt = (u.pn - 8) * BM; } else { base = V; ldc = 576; colt = (u.pn - 10) * BM; }
        const int col0 = colt + wc * 32 + 8 * fq;
        if (u.slab >= 0 || u.pn >= 10) {
#pragma unroll
            for (int ai = 0; ai < 2; ++ai)
#pragma unroll
                for (int m = 0; m < 4; ++m) { bf16_t* rowp = base + (size_t)(row0 + ai * HALF + m * 16) * ldc + col0;
#pragma unroll
                    for (int bj = 0; bj < 2; ++bj) *(u32x4*)(rowp + bj * HALF) = pack8(acc[ai][bj][m][0], acc[ai][bj][m][1]); }
            return;
        }
        const int lr0 = wr * 64 + fr;
        const float* g = (u.pn < 8) ? gq : gk; const int hc0 = wc * 32 + 8 * fq;
        const f32x4 g0 = *(const f32x4*)(g + hc0), g1 = *(const f32x4*)(g + hc0 + 4);
        const int f0 = (16 * wc + 4 * fq) & 31;
        f32x4 tab[4][2];
#pragma unroll
        for (int j = 0; j < 4; ++j) { const int pos = (wc < 2) ? (4 * (u.pm % 17) + wr + 2 * (j & 1)) : (fr + 16 * j);
            tab[j][0] = *(const f32x4*)(rope + (pos * 32 + f0) * 2); tab[j][1] = *(const f32x4*)(rope + (pos * 32 + f0 + 2) * 2); }
#pragma unroll
        for (int ai = 0; ai < 2; ++ai)
#pragma unroll
            for (int m = 0; m < 4; ++m)
#pragma unroll
                for (int bj = 0; bj < 2; ++bj) { const f32x4 a0 = acc[ai][bj][m][0], a1 = acc[ai][bj][m][1];
                    float s = ((a0[0] * a0[0] + a0[1] * a0[1]) + (a0[2] * a0[2] + a0[3] * a0[3])) + ((a1[0] * a1[0] + a1[1] * a1[1]) + (a1[2] * a1[2] + a1[3] * a1[3]));
                    s += __shfl_xor(s, 16); s += __shfl_xor(s, 32);
                    if (fq == 0) xt[((lr0 + ai * HALF + m * 16) * 2 + bj) * 4 + wc] = s; }
        asm volatile("s_waitcnt lgkmcnt(0)" ::: "memory"); __builtin_amdgcn_s_barrier(); asm volatile("" ::: "memory");
#pragma unroll
        for (int ai = 0; ai < 2; ++ai)
#pragma unroll
            for (int m = 0; m < 4; ++m) {
                const f32x4 c0 = (wc < 2) ? tab[ai][0] : tab[m][0], c1 = (wc < 2) ? tab[ai][1] : tab[m][1];
                bf16_t* rowp = base + (size_t)(row0 + ai * HALF + m * 16) * ldc + col0;
#pragma unroll
                for (int bj = 0; bj < 2; ++bj) { const f32x4 tv = *(const PG8_LAS f32x4*)(xt + ((lr0 + ai * HALF + m * 16) * 2 + bj) * 4);
                    const float rstd = rsq_f(((tv[0] + tv[1]) + (tv[2] + tv[3])) * (1.0f / 128.0f) + 1e-6f);
                    const f32x4 x0 = acc[ai][bj][m][0] * rstd * g0, x1 = acc[ai][bj][m][1] * rstd * g1;
                    const f32x4 y0 = (f32x4){x0[0] * c0[0] - x0[1] * c0[1], x0[0] * c0[1] + x0[1] * c0[0], x0[2] * c0[2] - x0[3] * c0[3], x0[2] * c0[3] + x0[3] * c0[2]};
                    const f32x4 y1 = (f32x4){x1[0] * c1[0] - x1[1] * c1[1], x1[0] * c1[1] + x1[1] * c1[0], x1[2] * c1[2] - x1[3] * c1[3], x1[2] * c1[3] + x1[3] * c1[2]};
                    *(u32x4*)(rowp + bj * HALF) = pack8(y0, y1); } }
    }
};
struct EpiSwiglu {
    static constexpr bool PERM = true, AFTER_DRAIN = false;
    bf16_t* H; int ldc;
    __device__ __forceinline__ void operator()(const f32x4 (&acc)[2][2][4][2], const Unit& u, int wr, int wc, int fr, int fq) const {
        const int row0 = u.pm * BM + wr * 64 + fr, col0 = u.pn * HALF + wc * 32 + 8 * fq;
#pragma unroll
        for (int ai = 0; ai < 2; ++ai)
#pragma unroll
            for (int m = 0; m < 4; ++m) { bf16_t* rowp = H + (size_t)(row0 + ai * HALF + m * 16) * ldc + col0;
                f32x4 r0, r1;
#pragma unroll
                for (int j = 0; j < 4; ++j) { const float g0 = acc[ai][0][m][0][j], g1 = acc[ai][0][m][1][j];
                    r0[j] = g0 * rcp_f(1.0f + __expf(-g0)) * acc[ai][1][m][0][j]; r1[j] = g1 * rcp_f(1.0f + __expf(-g1)) * acc[ai][1][m][1][j]; }
                *(u32x4*)rowp = pack8(r0, r1); }
    }
};
struct EpiInProj {
    static constexpr bool PERM = true, AFTER_DRAIN = false;
    bf16_t* PRJ; float* GATES; const float* bgate;
    __device__ __forceinline__ void operator()(const f32x4 (&acc)[2][2][4][2], const Unit& u, int wr, int wc, int fr, int fq) const {
        const int row0 = u.pm * BM + wr * 64 + fr;
        if (u.pn < 24) {
            const float sc = (u.pn < 4) ? 0.08838834764831845f : 1.0f; const bool sig = (u.pn >= 16);
            const int col0 = u.pn * BM + wc * 32 + 8 * fq;
#pragma unroll
            for (int ai = 0; ai < 2; ++ai)
#pragma unroll
                for (int m = 0; m < 4; ++m) { bf16_t* rowp = PRJ + (size_t)(row0 + ai * HALF + m * 16) * 6208 + col0;
#pragma unroll
                    for (int bj = 0; bj < 2; ++bj) { f32x4 v0 = acc[ai][bj][m][0] * sc, v1 = acc[ai][bj][m][1] * sc;
                        if (sig) {
#pragma unroll
                            for (int j = 0; j < 4; ++j) { v0[j] = rcp_f(1.0f + __expf(-v0[j])); v1[j] = rcp_f(1.0f + __expf(-v1[j])); } }
                        *(u32x4*)(rowp + bj * HALF) = pack8(v0, v1); } }
        } else if (wc == 0) {
#pragma unroll
            for (int ai = 0; ai < 2; ++ai)
#pragma unroll
                for (int m = 0; m < 4; ++m) { float* rowp = GATES + (size_t)(row0 + ai * HALF + m * 16) * 32 + 8 * fq;
#pragma unroll
                    for (int n = 0; n < 2; ++n) { f32x4 g;
#pragma unroll
                        for (int j = 0; j < 4; ++j) { float v = acc[ai][0][m][n][j] + bgate[8 * fq + 4 * n + j];
                            v = 15.0f - 30.0f * rcp_f(__expf(v * (2.0f / 15.0f)) + 1.0f);
                            if (fq & 1) v = fminf(v, 0.0f) - __logf(1.0f + __expf(-fabsf(v)));
                            g[j] = v; }
                        *(f32x4*)(rowp + 4 * n) = g; } }
        }
    }
};

struct EpiHeadNorm {
    static constexpr bool PERM = true, AFTER_DRAIN = false;
    const bf16_t* HF; const bf16_t* HB; bf16_t* O; int ldo; const float* gh;
    PG8_LAS float* xt;
    __device__ __forceinline__ void operator()(const f32x4 (&acc)[2][2][4][2], const Unit& u, int wr, int wc, int fr, int fq) const {
        const int lr0 = wr * 64 + fr, colh = u.pn * BM + wc * 32 + 8 * fq;
        const unsigned lofs = (unsigned)(((wr * 64 + fr) * 2112 + wc * 32 + 8 * fq) * 2);
        const char* hfu = (const char*)HF + ((size_t)u.pm * BM * 2112 + (size_t)u.pn * BM) * 2; const char* hbu = (const char*)HB + ((size_t)u.pm * BM * 2112 + (size_t)u.pn * BM) * 2;
        u32x4 sga[2][2][4];
#pragma unroll
        for (int ai = 0; ai < 2; ++ai)
#pragma unroll
            for (int bj = 0; bj < 2; ++bj)
#pragma unroll
                for (int m = 0; m < 4; ++m) { f32x4 v0, v1;
#pragma unroll
                    for (int j = 0; j < 4; ++j) { v0[j] = rcp_f(1.0f + __expf(-acc[ai][bj][m][0][j])); v1[j] = rcp_f(1.0f + __expf(-acc[ai][bj][m][1][j])); }
                    sga[ai][bj][m] = pack8(v0, v1); }
        __builtin_amdgcn_sched_barrier(0); asm volatile("" ::: "memory");
#pragma unroll
        for (int ai = 0; ai < 2; ++ai) {
            u32x4 hf[2][4], hb[2][4];
#pragma unroll
            for (int m = 0; m < 4; ++m)
#pragma unroll
                for (int bj = 0; bj < 2; ++bj) { const size_t uo = ((size_t)(ai * HALF + m * 16) * 2112 + bj * HALF) * 2;
                    hf[bj][m] = *(const u32x4*)(hfu + uo + lofs); hb[bj][m] = *(const u32x4*)(hbu + uo + lofs); }
            const u32x4 (&sg)[2][4] = sga[ai];
#pragma unroll
            for (int m = 0; m < 4; ++m)
#pragma unroll
                for (int bj = 0; bj < 2; ++bj) { const u32x4 f = hf[bj][m], b = hb[bj][m];
                    float s = 0.f;
#pragma unroll
                    for (int e = 0; e < 4; ++e) { const float h0 = bflo(f[e]) + bflo(b[e]), h1 = bfhi(f[e]) + bfhi(b[e]); s += h0 * h0 + h1 * h1; }
                    s += __shfl_xor(s, 16); s += __shfl_xor(s, 32);
                    if (fq == 0) xt[(lr0 + ai * HALF + m * 16) * 8 + bj * 4 + wc] = s; }
            asm volatile("s_waitcnt lgkmcnt(0)" ::: "memory"); __builtin_amdgcn_s_barrier(); asm volatile("" ::: "memory");
            f32x4 g[2][2];
#pragma unroll
            for (int bj = 0; bj < 2; ++bj) { g[bj][0] = *(const f32x4*)(gh + colh + bj * HALF); g[bj][1] = *(const f32x4*)(gh + colh + bj * HALF + 4); }
#pragma unroll
            for (int m = 0; m < 4; ++m) { const int lr = lr0 + ai * HALF + m * 16;
                const f32x4 t0 = *(const PG8_LAS f32x4*)(xt + lr * 8), t1 = *(const PG8_LAS f32x4*)(xt + lr * 8 + 4);
                const float rstd = rsq_f((((t0[0] + t0[1]) + (t0[2] + t0[3])) + ((t1[0] + t1[1]) + (t1[2] + t1[3]))) * (1.0f / 256.0f) + 1e-6f);
                bf16_t* rowp = O + (size_t)(u.pm * BM + lr) * ldo + colh;
#pragma unroll
                for (int bj = 0; bj < 2; ++bj) { const u32x4 f = hf[bj][m], b = hb[bj][m], sgv = sg[bj][m];
                    f32x4 v0, v1;
#pragma unroll
                    for (int e = 0; e < 2; ++e) {
                        v0[2 * e] = (bflo(f[e]) + bflo(b[e])) * rstd * g[bj][0][2 * e] * bflo(sgv[e]);
                        v0[2 * e + 1] = (bfhi(f[e]) + bfhi(b[e])) * rstd * g[bj][0][2 * e + 1] * bfhi(sgv[e]);
                        v1[2 * e] = (bflo(f[e + 2]) + bflo(b[e + 2])) * rstd * g[bj][1][2 * e] * bflo(sgv[e + 2]);
                        v1[2 * e + 1] = (bfhi(f[e + 2]) + bfhi(b[e + 2])) * rstd * g[bj][1][2 * e + 1] * bfhi(sgv[e + 2]); }
                    *(u32x4*)(rowp + bj * HALF) = pack8(v0, v1); } }
        }
    }
};

template <class Epi, class Sched, bool ALIGN_EPI = false, bool SP2 = false>
__device__ __forceinline__ void gemm_phase(PG8_LAS unsigned char* lds, const Gemm g, const Sched& S, const Epi& E) {
    const int tid = threadIdx.x, wid = __builtin_amdgcn_readfirstlane(tid >> 6), lane = tid & 63, wr = wid >> 2, wc = wid & 3, fr = lane & 15, fq = lane >> 4;
    unsigned voffA[2], voffB[2];
#pragma unroll
    for (int i = 0; i < 2; ++i) { int R, C; stage_rc(tid * 16 + i * 8192, R, C); const int Rb = Epi::PERM ? ((R & ~31) + perm32(R & 31)) : R;
        voffA[i] = (unsigned)(R * g.lda + C) * 2u; voffB[i] = (unsigned)(Rb * g.ldb + C) * 2u; }
    const size_t kstep = (size_t)(BK * 2);
    const size_t hstepA = (size_t)HALF * g.lda * 2, hstepB = (size_t)HALF * g.ldb * 2;
    const size_t tstepA = 2 * hstepA, tstepB = 2 * hstepB;
    const unsigned ldsw = (unsigned)wid * 1024u;
    const int aoff = lds_byte(wr * 64 + fr, fq * 8), boff = lds_byte(wc * 32 + fr, fq * 8);
#define PG8_SA(b, h) (((b) * 2 + (h)) * HTB)
#define PG8_SB(b, h) ((4 + (b) * 2 + (h)) * HTB)
#define PG8_STAGE(bufoff, gbase, voff) do { _Pragma("unroll") for (int _i = 0; _i < 2; ++_i) \
        __builtin_amdgcn_global_load_lds((const unsigned*)((const char*)(gbase) + (voff)[_i]), (PG8_LAS unsigned*)(lds + (bufoff) + ldsw + _i * 8192), 16, 0, 0); } while (0)
#define PG8_LDA(dst, b, h) do { _Pragma("unroll") for (int m = 0; m < 4; ++m) _Pragma("unroll") for (int k = 0; k < 2; ++k) dst[m][k] = *(const PG8_LAS bf16x8*)(lds + PG8_SA(b, h) + aoff + m * 2048 + k * 1024); } while (0)
#define PG8_LDB(dst, b, h) do { _Pragma("unroll") for (int n = 0; n < 2; ++n) _Pragma("unroll") for (int k = 0; k < 2; ++k) dst[n][k] = *(const PG8_LAS bf16x8*)(lds + PG8_SB(b, h) + boff + n * 2048 + k * 1024); } while (0)
#define PG8_MMA(ai, bj, At, Bt) do { __builtin_amdgcn_s_setprio(1); _Pragma("unroll") for (int m = 0; m < 4; ++m) _Pragma("unroll") for (int n = 0; n < 2; ++n) _Pragma("unroll") for (int k = 0; k < 2; ++k) \
        acc[ai][bj][m][n] = __builtin_amdgcn_mfma_f32_16x16x32_bf16(Bt[n][k], At[m][k], acc[ai][bj][m][n], 0, 0, 0); __builtin_amdgcn_s_setprio(0); } while (0)
#define PG8_WAIT_V(n) asm volatile("s_waitcnt vmcnt(" #n ")" ::: "memory")
#define PG8_WAIT_L(n) asm volatile("s_waitcnt lgkmcnt(" #n ")" ::: "memory")
#define PG8_BAR __builtin_amdgcn_s_barrier()
#define PG8_SCHED __builtin_amdgcn_sched_barrier(0)
    Unit cur, nxt; int ui = 0;
    if (!S.next(0, cur)) return;
    f32x4 acc[2][2][4][2];
#pragma unroll
    for (int a = 0; a < 2; ++a)
#pragma unroll
        for (int b = 0; b < 2; ++b)
#pragma unroll
            for (int m = 0; m < 4; ++m)
#pragma unroll
                for (int n = 0; n < 2; ++n) acc[a][b][m][n] = (f32x4){0.f, 0.f, 0.f, 0.f};
    bf16x8 At[4][2], B0[2][2], B1[2][2];
    const char* cA = (const char*)g.A + (size_t)cur.pm * tstepA + (size_t)cur.kt0 * kstep; const char* cB = (const char*)g.Bt + (size_t)cur.pn * tstepB + (size_t)cur.kt0 * kstep;
    S.a_ready(cur);
    if constexpr (SP2) {
        PG8_STAGE(PG8_SB(0, 0), cB, voffB); PG8_STAGE(PG8_SB(0, 1), cB + hstepB, voffB); PG8_STAGE(PG8_SA(0, 0), cA, voffA); PG8_STAGE(PG8_SA(0, 1), cA + hstepA, voffA);
        if (wr == 1) PG8_BAR;
        PG8_WAIT_V(2); PG8_BAR;
        PG8_STAGE(PG8_SB(1, 0), cB + kstep, voffB); PG8_STAGE(PG8_SA(1, 0), cA + kstep, voffA); PG8_STAGE(PG8_SB(1, 1), cB + hstepB + kstep, voffB);
        PG8_WAIT_V(6); PG8_BAR;
    } else {
        PG8_STAGE(PG8_SB(0, 0), cB, voffB); PG8_STAGE(PG8_SA(0, 0), cA, voffA); PG8_STAGE(PG8_SB(0, 1), cB + hstepB, voffB); PG8_STAGE(PG8_SA(0, 1), cA + hstepA, voffA);
        if (wr == 1) PG8_BAR;
        PG8_WAIT_V(4); PG8_BAR;
        PG8_STAGE(PG8_SB(1, 0), cB + kstep, voffB); PG8_STAGE(PG8_SA(1, 0), cA + kstep, voffA); PG8_STAGE(PG8_SB(1, 1), cB + hstepB + kstep, voffB);
        PG8_WAIT_V(6); PG8_BAR;
    }
    for (;;) {
        const bool has_next = S.next(ui + 1, nxt);
        const char* nA = has_next ? (const char*)g.A + (size_t)nxt.pm * tstepA + (size_t)nxt.kt0 * kstep : cA; const char* nB = has_next ? (const char*)g.Bt + (size_t)nxt.pn * tstepB + (size_t)nxt.kt0 * kstep : cB;
        const int cnt = cur.nt;
        for (int t = 0; t < cnt; t += 2) {
            const bool last = (t == cnt - 2);
            const char* a1 = cA + (size_t)(t + 1) * kstep;
            const char* a2 = last ? nA : cA + (size_t)(t + 2) * kstep; const char* b2 = last ? nB : cB + (size_t)(t + 2) * kstep;
            const char* a3 = a2 + kstep; const char* b3 = b2 + kstep;
            if (last && has_next) S.a_ready(nxt);
            if constexpr (SP2) {
            PG8_LDB(B0, 0, 0); PG8_LDB(B1, 0, 1); PG8_SCHED; PG8_LDA(At, 0, 0); PG8_STAGE(PG8_SA(1, 1), a1 + hstepA, voffA);
            PG8_WAIT_V(8); PG8_WAIT_L(0); PG8_BAR; PG8_MMA(0, 0, At, B0); PG8_MMA(0, 1, At, B1); PG8_BAR; PG8_SCHED;
            PG8_LDA(At, 0, 1); PG8_STAGE(PG8_SB(0, 0), b2, voffB); PG8_STAGE(PG8_SB(0, 1), b2 + hstepB, voffB); PG8_STAGE(PG8_SA(0, 0), a2, voffA);
            PG8_WAIT_V(8); PG8_WAIT_L(0); PG8_BAR; PG8_MMA(1, 0, At, B0); PG8_MMA(1, 1, At, B1); PG8_BAR; PG8_SCHED;
            PG8_LDB(B0, 1, 0); PG8_LDB(B1, 1, 1); PG8_SCHED; PG8_LDA(At, 1, 0); PG8_STAGE(PG8_SA(0, 1), a2 + hstepA, voffA);
            PG8_WAIT_V(8); PG8_WAIT_L(0); PG8_BAR; PG8_MMA(0, 0, At, B0); PG8_MMA(0, 1, At, B1); PG8_BAR; PG8_SCHED;
            PG8_LDA(At, 1, 1); PG8_STAGE(PG8_SB(1, 0), b3, voffB); PG8_STAGE(PG8_SB(1, 1), b3 + hstepB, voffB); PG8_STAGE(PG8_SA(1, 0), a3, voffA);
            PG8_WAIT_V(8); PG8_WAIT_L(0); PG8_BAR; PG8_MMA(1, 0, At, B0); PG8_MMA(1, 1, At, B1); PG8_BAR; PG8_SCHED;
            } else {
            PG8_LDB(B0, 0, 0); PG8_SCHED; PG8_LDA(At, 0, 0); PG8_STAGE(PG8_SA(1, 1), a1 + hstepA, voffA);
            PG8_WAIT_L(8); PG8_BAR; PG8_WAIT_L(0); PG8_MMA(0, 0, At, B0); PG8_BAR; PG8_SCHED;
            PG8_LDB(B1, 0, 1); PG8_STAGE(PG8_SB(0, 0), b2, voffB);
            PG8_BAR; PG8_WAIT_L(0); PG8_MMA(0, 1, At, B1); PG8_BAR;
            PG8_LDA(At, 0, 1); PG8_STAGE(PG8_SA(0, 0), a2, voffA);
            PG8_BAR; PG8_WAIT_L(0); PG8_MMA(1, 0, At, B0); PG8_BAR; PG8_SCHED;
            PG8_STAGE(PG8_SB(0, 1), b2 + hstepB, voffB);
            PG8_WAIT_V(6); PG8_BAR; PG8_MMA(1, 1, At, B1); PG8_BAR;
            PG8_LDB(B0, 1, 0); PG8_SCHED; PG8_LDA(At, 1, 0); PG8_STAGE(PG8_SA(0, 1), a2 + hstepA, voffA);
            PG8_WAIT_L(8); PG8_BAR; PG8_WAIT_L(0); PG8_MMA(0, 0, At, B0); PG8_BAR; PG8_SCHED;
            PG8_LDB(B1, 1, 1); PG8_STAGE(PG8_SB(1, 0), b3, voffB);
            PG8_BAR; PG8_WAIT_L(0); PG8_MMA(0, 1, At, B1); PG8_BAR;
            PG8_LDA(At, 1, 1); PG8_STAGE(PG8_SA(1, 0), a3, voffA);
            PG8_BAR; PG8_WAIT_L(0); PG8_MMA(1, 0, At, B0); PG8_BAR; PG8_SCHED;
            PG8_STAGE(PG8_SB(1, 1), b3 + hstepB, voffB);
            PG8_WAIT_V(6); PG8_BAR; PG8_MMA(1, 1, At, B1); PG8_BAR;
            }
        }
        if constexpr (ALIGN_EPI) { if (wr == 0) PG8_BAR; }
        if constexpr (!Epi::AFTER_DRAIN) { E(acc, cur, wr, wc, fr, fq); S.done(cur); }
        if (!has_next) break;
#pragma unroll
        for (int a = 0; a < 2; ++a)
#pragma unroll
            for (int b = 0; b < 2; ++b)
#pragma unroll
                for (int m = 0; m < 4; ++m)
#pragma unroll
                    for (int n = 0; n < 2; ++n) acc[a][b][m][n] = (f32x4){0.f, 0.f, 0.f, 0.f};
        cur = nxt; cA = nA; cB = nB; ++ui;
        if constexpr (ALIGN_EPI) { if (wr == 1) PG8_BAR; }
    }
    PG8_WAIT_V(0);
    if constexpr (!ALIGN_EPI) { if (wr == 0) PG8_BAR; }
    PG8_BAR;
    if constexpr (Epi::AFTER_DRAIN) { E.fused(acc, cur, wr, wc, fr, fq, lds, wid, lane); S.done(cur); }
#undef PG8_SA
#undef PG8_SB
#undef PG8_STAGE
#undef PG8_LDA
#undef PG8_LDB
#undef PG8_MMA
#undef PG8_WAIT_V
#undef PG8_WAIT_L
#undef PG8_BAR
#undef PG8_SCHED
}
}
namespace att {
using bf16 = unsigned short;
constexpr int   D = 128, NW = 8, QBLK = 32, KVBLK = 64;
constexpr float SCALE = 0.088388347648318440f;
constexpr float THR = 8.f;
constexpr int SDEPTH = 2;
constexpr int LDQ = 2112, LDK = 576, LDO = 2112;
constexpr size_t SHM_V = KVBLK * D * 2, SHM_K = KVBLK * D * 2, SHM_ATTN = 2 * SHM_V + 2 * SHM_K + NW * 64 * 4;
using bf16x8 = __attribute__((ext_vector_type(8))) short;
using s16x4  = __attribute__((ext_vector_type(4))) short;
using f32x16 = __attribute__((ext_vector_type(16))) float;
using f32x8  = __attribute__((ext_vector_type(8))) float;
using u32x4  = __attribute__((ext_vector_type(4))) unsigned;
#define KSWZ(row, colB) ((row) * 256 + ((colB) ^ (((row) & 7) << 4)))
#define SBAR() __builtin_amdgcn_sched_barrier(0)
__device__ __forceinline__ int crow(int r, int hi) { return (r & 3) + 8 * (r >> 2) + 4 * hi; }
__device__ __forceinline__ unsigned cvtpk(float lo, float hi) {
  unsigned r; asm volatile("v_cvt_pk_bf16_f32 %0, %1, %2" : "=v"(r) : "v"(lo), "v"(hi)); return r;
}
template <typename TIn> struct Stage;
template <> struct Stage<bf16>  { using T = bf16x8;
  __device__ static __forceinline__ T ld8(const bf16* p) { return *reinterpret_cast<const bf16x8*>(p); }
  __device__ static __forceinline__ bf16x8 tobf(T x) { return x; } };
template <> struct Stage<float> { using T = f32x8;
  __device__ static __forceinline__ T ld8(const float* p) { return *reinterpret_cast<const f32x8*>(p); }
  __device__ static __forceinline__ bf16x8 tobf(T x) {
    u32x4 w = {cvtpk(x[0], x[1]), cvtpk(x[2], x[3]), cvtpk(x[4], x[5]), cvtpk(x[6], x[7])}; return *reinterpret_cast<bf16x8*>(&w); } };

__device__ __forceinline__ void partialSM(f32x16& p0, f32x16& p1, float& m_reg, float& mn, float& alpha) {
  constexpr float C = SCALE * 1.4426950408889634f;
  float pmax = p0[0]; for (int r = 1; r < 16; ++r) pmax = fmaxf(pmax, p0[r]); for (int r = 0; r < 16; ++r) pmax = fmaxf(pmax, p1[r]);
  { auto rr = __builtin_amdgcn_permlane32_swap(__float_as_uint(pmax), __float_as_uint(pmax), false, false);
    pmax = fmaxf(__uint_as_float(rr[0]), __uint_as_float(rr[1])); }
  if (__builtin_expect(__all(pmax - m_reg <= THR / SCALE), 1)) { mn = m_reg; alpha = 1.f; }
  else { mn = fmaxf(m_reg, pmax); alpha = __builtin_amdgcn_exp2f((m_reg - mn) * C); m_reg = mn; }
  float mnC = -mn * C;
  for (int r = 0; r < 16; ++r) p0[r] = fmaf(p0[r], C, mnC); for (int r = 0; r < 16; ++r) p1[r] = fmaf(p1[r], C, mnC);
  for (int r = 0; r < 16; ++r) p0[r] = __builtin_amdgcn_exp2f(p0[r]);
}
__device__ __forceinline__ void finishSM(f32x16& p0, f32x16& p1, float alpha, float& l_reg, bf16x8& pa0, bf16x8& pa1, bf16x8& pa2, bf16x8& pa3) {
  for (int r = 0; r < 16; ++r) p1[r] = __builtin_amdgcn_exp2f(p1[r]);
  float ps = 0; for (int r = 0; r < 16; ++r) ps += p0[r]; for (int r = 0; r < 16; ++r) ps += p1[r];
  { auto rr = __builtin_amdgcn_permlane32_swap(__float_as_uint(ps), __float_as_uint(ps), false, false);
    ps = __uint_as_float(rr[0]) + __uint_as_float(rr[1]); }
  l_reg = l_reg * alpha + ps;
#define PK4(P, BASE, OUT) do { unsigned a0 = cvtpk(P[BASE + 0], P[BASE + 1]), a1 = cvtpk(P[BASE + 2], P[BASE + 3]);   \
    unsigned b0 = cvtpk(P[BASE + 4], P[BASE + 5]), b1 = cvtpk(P[BASE + 6], P[BASE + 7]);                              \
    auto r0 = __builtin_amdgcn_permlane32_swap(a0, b0, false, false); auto r1 = __builtin_amdgcn_permlane32_swap(a1, b1, false, false); \
    u32x4 w = {r0[0], r1[0], r0[1], r1[1]}; OUT = *reinterpret_cast<bf16x8*>(&w); } while (0)
  PK4(p0, 0, pa0); PK4(p0, 8, pa1); PK4(p1, 0, pa2); PK4(p1, 8, pa3);
#undef PK4
}
__device__ __forceinline__ void qkt(f32x16& p0, f32x16& p1, const bf16* Ks, const bf16x8* qr, int r32, int hi) {
  p0 = f32x16{}; p1 = f32x16{};
  for (int d0 = 0; d0 < 8; ++d0) { int cb = (d0 * 16 + hi * 8) * 2;
    bf16x8 b0 = *reinterpret_cast<const bf16x8*>((const char*)Ks + KSWZ(r32, cb));
    bf16x8 b1 = *reinterpret_cast<const bf16x8*>((const char*)Ks + KSWZ(32 + r32, cb));
    p0 = __builtin_amdgcn_mfma_f32_32x32x16_bf16(b0, qr[d0], p0, 0, 0, 0);
    p1 = __builtin_amdgcn_mfma_f32_32x32x16_bf16(b1, qr[d0], p1, 0, 0, 0); }
}
__device__ __forceinline__ int v_st(int k, int c) { const int kk = (k & ~0xC) | ((k & 4) << 1) | ((k & 8) >> 1); return ((kk >> 3) * 4 + (c >> 5)) * 512 + ((kk & 7) * 32 + (c & 31)) * 2; }
__device__ __forceinline__ int v_rd_base(int lane) { return ((lane & 3) << 3) | (((lane >> 2) & 3) << 6) | (((lane >> 4) & 1) << 5) | (((lane >> 5) & 1) << 8); }
constexpr int v_rd_off(int d0, int ks, int half) { return d0 * 512 + ks * 4096 + half * 2048; }
template <int OFF> __device__ __forceinline__ s16x4 tr_read(int vb) {
  s16x4 r; asm volatile("ds_read_b64_tr_b16 %0, %1 offset:%2" : "=&v"(r) : "v"(vb), "i"(OFF) : "memory"); return r;
}
template <int D0> __device__ __forceinline__ void pv_one(f32x16& od, int vb, bf16x8 pa0, bf16x8 pa1, bf16x8 pa2, bf16x8 pa3) {
  const s16x4 l0 = tr_read<v_rd_off(D0, 0, 0)>(vb), h0 = tr_read<v_rd_off(D0, 0, 1)>(vb), l1 = tr_read<v_rd_off(D0, 1, 0)>(vb), h1 = tr_read<v_rd_off(D0, 1, 1)>(vb);
  const s16x4 l2 = tr_read<v_rd_off(D0, 2, 0)>(vb), h2 = tr_read<v_rd_off(D0, 2, 1)>(vb), l3 = tr_read<v_rd_off(D0, 3, 0)>(vb), h3 = tr_read<v_rd_off(D0, 3, 1)>(vb);
  asm volatile("s_waitcnt lgkmcnt(0)" ::: "memory"); SBAR();
#define PK(L, H) (bf16x8){L[0], L[1], L[2], L[3], H[0], H[1], H[2], H[3]}
  od = __builtin_amdgcn_mfma_f32_32x32x16_bf16(pa0, PK(l0, h0), od, 0, 0, 0);
  od = __builtin_amdgcn_mfma_f32_32x32x16_bf16(pa1, PK(l1, h1), od, 0, 0, 0);
  od = __builtin_amdgcn_mfma_f32_32x32x16_bf16(pa2, PK(l2, h2), od, 0, 0, 0);
  od = __builtin_amdgcn_mfma_f32_32x32x16_bf16(pa3, PK(l3, h3), od, 0, 0, 0);
#undef PK
}
__device__ __forceinline__ void pv_d0(f32x16* o, int vb, bf16x8 pa0, bf16x8 pa1, bf16x8 pa2, bf16x8 pa3) {
  pv_one<0>(o[0], vb, pa0, pa1, pa2, pa3); pv_one<1>(o[1], vb, pa0, pa1, pa2, pa3); pv_one<2>(o[2], vb, pa0, pa1, pa2, pa3); pv_one<3>(o[3], vb, pa0, pa1, pa2, pa3);
}

template <typename TQ>
__device__ __forceinline__ void attn_dense_body(const TQ* __restrict__ Qb, const bf16* __restrict__ Kh, const bf16* __restrict__ Vh,
                                                bf16* __restrict__ Ob, int seq, char* lds) {
  using St = Stage<bf16>; using SQ = Stage<TQ>;
  const int tid = threadIdx.x, wid = tid >> 6, lane = tid & 63, r32 = lane & 31, hi = lane >> 5;
  bf16* V_lds = (bf16*)lds; bf16* K_lds = (bf16*)(lds + 2 * SHM_V);
  float* ws = (float*)(lds + 2 * SHM_V + 2 * SHM_K) + wid * 64; float* li_l = ws; float* al_l = ws + 32;
  float m_reg = -1e30f, l_reg = 0; f32x16 o[4] = {}; bf16x8 qr[8];
  const TQ* Qw = Qb + (long)(wid * QBLK + r32) * LDQ + hi * 8;
#pragma unroll
  for (int d0 = 0; d0 < 8; ++d0) qr[d0] = SQ::tobf(SQ::ld8(Qw + d0 * 16));
  const int sr = tid >> 4, sc = (tid & 15) * 8, vst0 = v_st(sr, sc), vst1 = v_st(32 + sr, sc);
  const int vb0 = (int)(uintptr_t)V_lds + v_rd_base(lane);
  struct { typename St::T vs0, vs1, ks0, ks1; } sr_[SDEPTH];
#define SLOAD(i, k0) do { sr_[i].vs0 = St::ld8(&Vh[(long)((k0) + sr) * LDK + sc]); sr_[i].vs1 = St::ld8(&Vh[(long)((k0) + 32 + sr) * LDK + sc]); \
    sr_[i].ks0 = St::ld8(&Kh[(long)((k0) + sr) * LDK + sc]); sr_[i].ks1 = St::ld8(&Kh[(long)((k0) + 32 + sr) * LDK + sc]); } while (0)
#define SWRITE(b, i) do { *(bf16x8*)((char*)V_lds + (b) * SHM_V + vst0) = St::tobf(sr_[i].vs0);          \
    *(bf16x8*)((char*)V_lds + (b) * SHM_V + vst1) = St::tobf(sr_[i].vs1); int kc = sc * 2;               \
    *(bf16x8*)((char*)K_lds + (b) * SHM_K + KSWZ(sr, kc)) = St::tobf(sr_[i].ks0);                       \
    *(bf16x8*)((char*)K_lds + (b) * SHM_K + KSWZ(32 + sr, kc)) = St::tobf(sr_[i].ks1); } while (0)
#define SWAIT() do { if constexpr (SDEPTH == 2) asm volatile("s_waitcnt vmcnt(4)" ::: "memory"); else asm volatile("s_waitcnt vmcnt(0)" ::: "memory"); } while (0)
#define RESC(a) do { if (__any((a) < 1.f)) { if (hi == 0) al_l[r32] = (a); asm volatile("s_waitcnt lgkmcnt(0)" ::: "memory"); \
    for (int d = 0; d < 4; ++d) for (int r = 0; r < 16; ++r) o[d][r] *= al_l[crow(r, hi)]; } } while (0)
  f32x16 pA0, pA1, pB0, pB1; float mnA, mnB, alA, alB; bf16x8 pa0, pa1, pa2, pa3; const int NT = seq / KVBLK;
  constexpr int SE = 0, SO = SDEPTH - 1;
  SLOAD(SE, 0); asm volatile("s_waitcnt vmcnt(0)" ::: "memory"); SWRITE(0, SE); __syncthreads();
  qkt(pA0, pA1, K_lds, qr, r32, hi); partialSM(pA0, pA1, m_reg, mnA, alA);
  SLOAD(SO, KVBLK); if constexpr (SDEPTH == 2) { if (2 < NT) SLOAD(SE, 2 * KVBLK); }
  SWAIT(); SWRITE(1, SO); __syncthreads();
  for (int j = 1; j + 1 < NT; j += 2) {
    SBAR(); qkt(pB0, pB1, (bf16*)((char*)K_lds + SHM_K), qr, r32, hi);
    finishSM(pA0, pA1, alA, l_reg, pa0, pa1, pa2, pa3); SBAR();
    SLOAD(SO, (j + SDEPTH) * KVBLK); SBAR();
    pv_d0(o, vb0, pa0, pa1, pa2, pa3); partialSM(pB0, pB1, m_reg, mnB, alB);
    __syncthreads(); SWAIT(); SWRITE(0, SE);
    RESC(alB); __syncthreads();
    SBAR(); qkt(pA0, pA1, K_lds, qr, r32, hi);
    finishSM(pB0, pB1, alB, l_reg, pa0, pa1, pa2, pa3); SBAR();
    SLOAD(SE, ((j + 1 + SDEPTH < NT) ? (j + 1 + SDEPTH) : (NT - 1)) * KVBLK); SBAR();
    pv_d0(o, vb0 + (int)SHM_V, pa0, pa1, pa2, pa3); partialSM(pA0, pA1, m_reg, mnA, alA);
    __syncthreads(); SWAIT(); SWRITE(1, SO);
    RESC(alA); __syncthreads();
  }
  SBAR(); qkt(pB0, pB1, (bf16*)((char*)K_lds + SHM_K), qr, r32, hi);
  finishSM(pA0, pA1, alA, l_reg, pa0, pa1, pa2, pa3); SBAR();
  pv_d0(o, vb0, pa0, pa1, pa2, pa3); partialSM(pB0, pB1, m_reg, mnB, alB);
  __syncthreads(); RESC(alB);
  finishSM(pB0, pB1, alB, l_reg, pa0, pa1, pa2, pa3); SBAR();
  pv_d0(o, vb0 + (int)SHM_V, pa0, pa1, pa2, pa3);
  if (hi == 0) li_l[r32] = l_reg; asm volatile("s_waitcnt lgkmcnt(0)" ::: "memory");
  float rli[16];
#pragma unroll
  for (int r = 0; r < 16; ++r) rli[r] = __builtin_amdgcn_rcpf(li_l[crow(r, hi)]);
  bf16* Ow = Ob + (long)(wid * QBLK) * LDO;
  char* Ot = lds + SHM_ATTN + 1024 + wid * (32 * 272);
#pragma unroll
  for (int r = 0; r < 16; ++r) { int orow = crow(r, hi);
#pragma unroll
    for (int d0 = 0; d0 < 4; ++d0) *(bf16*)(Ot + orow * 272 + (d0 * 32 + r32) * 2) = (bf16)(cvtpk(o[d0][r] * rli[r], 0.f) & 0xffffu); }
  asm volatile("s_waitcnt lgkmcnt(0)" ::: "memory");
#pragma unroll
  for (int j = 0; j < 8; ++j) { const int c = lane + 64 * j, orow = c >> 4, c16 = c & 15;
    *reinterpret_cast<u32x4*>(Ow + (long)orow * LDO + c16 * 8) = *reinterpret_cast<const u32x4*>(Ot + orow * 272 + c16 * 16); }
#undef SLOAD
#undef SWRITE
#undef SWAIT
#undef RESC
}
}
#define XB_TMO      128
#define XB_XCNT(j)  (256  + 64 * (j))
#define XB_XSUB(j)  (1280 + 64 * (j))
#define XB_XGEN(j)  (2304 + 64 * (j))
#define XB_TOP      3328
#define XB_TOPGEN   3392
#define XCD_BAR_WORDS 3456
#define XB_SPIN_CAP (1u << 18)
#define LAS __attribute__((address_space(3)))

__device__ __forceinline__ unsigned xb_ld(unsigned* p)              { return __hip_atomic_load(p, __ATOMIC_RELAXED, __HIP_MEMORY_SCOPE_AGENT); }
__device__ __forceinline__ unsigned xb_add(unsigned* p, unsigned v) { return __hip_atomic_fetch_add(p, v, __ATOMIC_RELAXED, __HIP_MEMORY_SCOPE_AGENT); }
__device__ __forceinline__ unsigned xb_xcc_id() { return (unsigned)__builtin_amdgcn_s_getreg((3 << 11) | 20) & 0xFu; }
#define XB_SPIN(cond, bar) do { unsigned _sp = 0; while (cond) { __builtin_amdgcn_s_sleep(1); \
    if ((++_sp & 255u) == 0u) { if (xb_ld(&(bar)[XB_TMO])) break; if (_sp > XB_SPIN_CAP) { atomicAdd(&(bar)[XB_TMO], 1u); break; } } } } while (0)

struct XcdBarrier {
    unsigned* bar; unsigned x;
    volatile LAS unsigned* st;
};

__device__ __forceinline__ XcdBarrier xcd_barrier_post(unsigned* bar, volatile LAS unsigned* st) {
    XcdBarrier b; b.bar = bar; b.x = xb_xcc_id(); b.st = st;
    if (threadIdx.x == 0) (void)xb_add(&bar[XB_XCNT(b.x)], 1u);
    return b;
}
__device__ __forceinline__ void xcd_barrier_complete(unsigned* bar, unsigned x, unsigned& nloc, unsigned& nx) {
    const unsigned G = gridDim.x * gridDim.y * gridDim.z;
    unsigned sum, cnt, mine, sp = 0u;
    for (;;) {
        sum = 0u; cnt = 0u; mine = 0u;
#pragma unroll
        for (unsigned j = 0; j < 16; ++j) { const unsigned c = xb_ld(&bar[XB_XCNT(j)]); sum += c; cnt += (c > 0u) ? 1u : 0u; mine = (j == x) ? c : mine; }
        if (sum == G) break;
        __builtin_amdgcn_s_sleep(1);
        if ((++sp & 255u) == 0u) { if (xb_ld(&bar[XB_TMO])) break; if (sp > XB_SPIN_CAP) { atomicAdd(&bar[XB_TMO], 1u); break; } }
    }
    nloc = mine > 0u ? mine : 1u; nx = cnt > 0u ? cnt : 1u;
}

__device__ __forceinline__ void xcd_barrier(const XcdBarrier& b) {
    asm volatile("s_waitcnt vmcnt(0)" ::: "memory");
    __syncthreads();
    if (threadIdx.x == 0) {
        unsigned* bar = b.bar;
        __builtin_amdgcn_s_waitcnt(0);
        unsigned nloc = b.st[0], nx = b.st[1];
        if (nloc == 0u) { xcd_barrier_complete(bar, b.x, nloc, nx); b.st[0] = nloc; b.st[1] = nx; }
        const unsigned old = xb_add(&bar[XB_XSUB(b.x)], 1u);
        const unsigned gen = old / nloc;
        if (old + 1u == (gen + 1u) * nloc) {
            __builtin_amdgcn_fence(__ATOMIC_RELEASE, "agent");
            asm volatile("s_waitcnt vmcnt(0)" ::: "memory");
            const unsigned og = xb_add(&bar[XB_TOP], 1u);
            const unsigned tg = og / nx;
            asm volatile("buffer_inv sc1" ::: "memory");
            if (og + 1u == (tg + 1u) * nx) {
#pragma unroll
                for (unsigned j = 0; j < 16; ++j) xb_add(&bar[XB_XGEN(j)], 1u);
            } else XB_SPIN(xb_ld(&bar[XB_XGEN(b.x)]) == gen, bar);
            asm volatile("s_waitcnt vmcnt(0)" ::: "memory");
        } else {
            asm volatile("buffer_inv sc1" ::: "memory");
            XB_SPIN(xb_ld(&bar[XB_XGEN(b.x)]) == gen, bar);
            asm volatile("s_waitcnt vmcnt(0)" ::: "memory");
        }
    }
    __syncthreads();
}

struct Args { const float* in[20]; float* out; unsigned char* ws; int ph_lo, ph_hi, li, pad; };
struct Frame {
    LAS unsigned char* lds; volatile LAS unsigned* MISC;
    int tid, lane, wave, G, vcu, bx;
    unsigned char* ws;
};
enum { IN_X = 0, IN_C, IN_CTX, IN_CCTX, IN_WMOD, IN_BMOD, IN_GMIXPRE, IN_GMIXPOST, IN_GFFNPRE, IN_GFFNPOST, IN_WMIN, IN_BGATE, IN_GHEAD, IN_WMOUT, IN_WQKV, IN_GQ, IN_GK, IN_WAOUT, IN_WFFIN, IN_WFFOUT };

__device__ __forceinline__ void p0_tile(const float* W, int K, int N, bf16_t* WT, int ldw, int mode, LAS unsigned char* scr, int item, int lane) {
    const int nblk = (N + 127) / 128, kb = item / nblk, nb = item % nblk, k0 = 64 * kb, n00 = 128 * nb;
    const int nq = lane & 15, kp = lane >> 4;
    f32x4 va[2][8], vb[2][8];
#pragma unroll
    for (int hf = 0; hf < 2; ++hf) { const int n0 = n00 + 64 * hf;
        const int ncl = (n0 + 4 * nq < N - 4) ? (n0 + 4 * nq) : (N - 4);
        const float* src = W + (size_t)(k0 + 2 * kp) * N + ncl;
#pragma unroll
        for (int i = 0; i < 8; ++i) { va[hf][i] = *(const f32x4*)(src + (size_t)(8 * i) * N); vb[hf][i] = *(const f32x4*)(src + (size_t)(8 * i + 1) * N); } }
    LAS unsigned char* wbase = scr + (4 * nq) * 144 + 4 * kp; const int xs = (nq & 7) << 4;
    const int kc = lane & 7;
#pragma unroll
    for (int hf = 0; hf < 2; ++hf) { const int n0 = n00 + 64 * hf;
        int d0 = n0;
        if (mode == 1) { if (n0 < FF) d0 = 256 * (n0 / 128) + (n0 % 128); else { const int c2 = n0 - FF; d0 = 256 * (c2 / 128) + 128 + (c2 % 128); } }
#pragma unroll
        for (int i = 0; i < 8; ++i) { LAS unsigned char* pi = wbase + ((i << 4) ^ xs);
#pragma unroll
            for (int j = 0; j < 4; ++j) *(LAS unsigned*)(pi + j * 144) = cvtpk2(va[hf][i][j], vb[hf][i][j]); }
        LDS_WAIT(); asm volatile("" ::: "memory");
        v4u ov[8];
#pragma unroll
        for (int jn = 0; jn < 8; ++jn) { const int n = (lane >> 3) + 8 * jn; ov[jn] = *(const LAS v4u*)(scr + n * 144 + ((kc ^ ((n >> 2) & 7)) << 4)); }
#pragma unroll
        for (int jn = 0; jn < 8; ++jn) { const int n = (lane >> 3) + 8 * jn;
            if (n0 + n < N) *(GAS v4u*)(WT + (size_t)(d0 + n) * ldw + k0 + 8 * kc) = ov[jn]; }
        LDS_WAIT(); asm volatile("" ::: "memory");
    }
}

__device__ __forceinline__ void mod_cnd(Frame& F, const Args& a) {
    LAS float* cnd = (LAS float*)F.lds;
    __syncthreads();
    for (int i = F.tid; i < 5 * DM; i += NTHREADS) { const float cv = (i < 4 * DM) ? a.in[IN_C][i] : a.in[IN_CCTX][i - 4 * DM]; cnd[i] = silu_f(cv); }
    __syncthreads();
}
__device__ __forceinline__ void mod_item(Frame& F, const Args& a, int item) {
    const LAS float* cnd = (const LAS float*)F.lds;
    LAS float* red = (LAS float*)(F.lds + 40960);
    int lane = F.lane; asm volatile("" : "+v"(lane));
    const int l = item / 192, c0 = (item % 192) * 64, cq = lane & 15, rg = lane >> 4;
    const float* W = a.in[IN_WMOD] + (size_t)l * DM * NMOD + c0 + (size_t)(F.wave * 256) * NMOD;
    const unsigned lo = (unsigned)(16 * rg * NMOD + cq * 4);
    const LAS float* cl = cnd + F.wave * 256 + 16 * rg;
    f32x4 acc[5];
#pragma unroll
    for (int r = 0; r < 5; ++r) acc[r] = (f32x4){0.f, 0.f, 0.f, 0.f};
#pragma unroll 1
    for (int kk = 0; kk < 256; kk += 64) {
        f32x4 w[16];
#pragma unroll
        for (int i = 0; i < 16; ++i) w[i] = *(const f32x4*)(W + (size_t)(kk + i) * NMOD + lo);
#pragma unroll
        for (int q = 0; q < 4; ++q) {
            f32x4 cv[5];
#pragma unroll
            for (int r = 0; r < 5; ++r) cv[r] = *(const LAS f32x4*)(cl + r * DM + kk + 4 * q);
#pragma unroll
            for (int j = 0; j < 4; ++j)
#pragma unroll
                for (int r = 0; r < 5; ++r) acc[r] = acc[r] + w[4 * q + j] * cv[r][j];
        }
    }
#pragma unroll
    for (int r = 0; r < 5; ++r) *(LAS f32x4*)(red + ((F.wave * 4 + rg) * 5 + r) * 64 + cq * 4) = acc[r];
    __syncthreads();
    for (int o = F.tid; o < 5 * 64; o += NTHREADS) { const int r = o >> 6, n = o & 63; float s = 0.f;
#pragma unroll
        for (int w = 0; w < 32; ++w) s += red[(w * 5 + r) * 64 + n];
        ((float*)(F.ws + WS_MOD))[(size_t)(l * 5 + r) * NMOD + c0 + n] = s + a.in[IN_BMOD][l * NMOD + c0 + n]; }
    __syncthreads();
}
__device__ __forceinline__ void mod_drain(Frame& F, const Args& a, unsigned* ctr, int lo, int hi) {
    mod_cnd(F, a);
    for (;;) {
        if (F.tid == 0) F.MISC[16] = __hip_atomic_fetch_add(ctr, 1u, __ATOMIC_RELAXED, __HIP_MEMORY_SCOPE_AGENT);
        __syncthreads();
        const int it = lo + (int)F.MISC[16];
        __syncthreads();
        if (it >= hi) break;
        mod_item(F, a, it);
    }
}
constexpr int CV_IN = 32 * 49, CV_MO = 32 * 16, CV_QKV = 32 * 24, CV_AO = 32 * 16, CV_FI = 32 * 88, CV_FO = 88 * 16;
constexpr int CV_A0 = CV_IN, CV_B0 = CV_A0 + CV_MO + CV_FI + CV_FO, CV_END = CV_B0 + CV_QKV + CV_AO + CV_FI + CV_FO;
__device__ __forceinline__ void conv_items(Frame& F, const Args& a, unsigned* ctr, int lo, int hi, int grab) {
    unsigned char* ws = F.ws;
    LAS unsigned char* scr = F.lds + F.wave * 9216;
    int lane = F.lane; asm volatile("" : "+v"(lane));
    for (;;) {
        unsigned base = 0u;
        if (lane == 0) base = __hip_atomic_fetch_add(ctr, (unsigned)grab, __ATOMIC_RELAXED, __HIP_MEMORY_SCOPE_AGENT);
        base = (unsigned)__builtin_amdgcn_readfirstlane((int)base);
        if ((int)base >= hi - lo) break;
        for (int it = lo + (int)base; it < lo + (int)base + grab && it < hi; ++it) {
            int r = it;
            const float* W; bf16_t* WT; int K = DM, N, ldw = LDW, mode = 0;
            if (r < CV_IN) { W = a.in[IN_WMIN]; N = MIN_COLS; WT = (bf16_t*)(ws + WS_WIN); }
            else if ((r -= CV_IN) < CV_MO) { W = a.in[IN_WMOUT]; N = DM; WT = (bf16_t*)(ws + WS_WMO); }
            else if ((r -= CV_MO) < CV_FI) { W = a.in[IN_WFFIN]; N = 2 * FF; WT = (bf16_t*)(ws + WS_WFI); mode = 1; }
            else if ((r -= CV_FI) < CV_FO) { W = a.in[IN_WFFOUT]; K = FF; N = DM; WT = (bf16_t*)(ws + WS_WFO); ldw = LDWF; }
            else if ((r -= CV_FO) < CV_QKV) { W = a.in[IN_WQKV]; N = QKV_COLS; WT = (bf16_t*)(ws + WS_WQKV); }
            else if ((r -= CV_QKV) < CV_AO) { W = a.in[IN_WAOUT]; N = DM; WT = (bf16_t*)(ws + WS_WAO); }
            else if ((r -= CV_AO) < CV_FI) { W = a.in[IN_WFFIN] + (size_t)DM * 2 * FF; N = 2 * FF; WT = (bf16_t*)(ws + WS_WFI) + (size_t)2 * FF * LDW; mode = 1; }
            else { r -= CV_FI; W = a.in[IN_WFFOUT] + (size_t)FF * DM; K = FF; N = DM; WT = (bf16_t*)(ws + WS_WFO) + (size_t)DM * LDWF; ldw = LDWF; }
            p0_tile(W, K, N, WT, ldw, mode, scr, r, lane);
        }
    }
    __syncthreads();
}
__device__ __forceinline__ void phase_prep(Frame& F, const Args& a, unsigned* ctr) {
    unsigned char* ws = F.ws;
    if (F.bx < 64 || F.G < 64) { mod_cnd(F, a); for (int it = F.bx; it < 64; it += F.G) mod_item(F, a, it); }
    if (F.bx == F.G - 1) { float* gt = (float*)(ws + WS_ROPE); for (int i = F.tid; i < 64 * 32; i += NTHREADS) { const int pos = i >> 5, f = i & 31; const float inv = powf(10000.0f, -(float)(2 * f) / 64.0f); const float ang = (float)pos * inv; gt[2 * i] = cosf(ang); gt[2 * i + 1] = sinf(ang); } }
    GAS v4u* z = (GAS v4u*)((bf16_t*)(ws + WS_WIN) + (size_t)MIN_COLS * LDW);
    const int nz = (MIN_PAD - MIN_COLS) * LDW / 8;
    for (int i = F.bx * NTHREADS + F.tid; i < nz; i += F.G * NTHREADS) z[i] = (v4u){0u, 0u, 0u, 0u};
    conv_items(F, a, ctr, 0, CV_A0, 1);
}

struct RowCfg { int src_input, has_res, dst, has_h, do_ctx; int l_res, gate_idx; const float* gpost; int l_h, sh_idx, sc_idx; const float* gpre; };
struct RowRegs { f32x4 x[8]; v2u y[8]; };
__device__ __forceinline__ void row_load(RowRegs& r, const float* xrow, const bf16_t* xbrow, const bf16_t* yrow, int lane, int has_res) {
    if (xrow) {
#pragma unroll
        for (int j = 0; j < 8; ++j) r.x[j] = *(const f32x4*)(xrow + lane * 4 + 256 * j);
    } else {
#pragma unroll
        for (int j = 0; j < 8; ++j) { const v2u w = *(const v2u*)(xbrow + lane * 4 + 256 * j); r.x[j] = (f32x4){bflo(w.x), bfhi(w.x), bflo(w.y), bfhi(w.y)}; }
    }
    if (has_res) {
#pragma unroll
        for (int j = 0; j < 8; ++j) r.y[j] = *(const v2u*)(yrow + lane * 4 + 256 * j);
    }
}
__device__ __forceinline__ void row_compute(RowRegs& r, float* xdst, bf16_t* xbdst, bf16_t* hdst, const LAS float* VA, const LAS float* VB, const LAS float* VC, int lane, const RowCfg& cfg) {
    asm volatile("" ::: "memory");
    if (cfg.has_res) {
        f32x4 y[8]; float ss = 0.f;
#pragma unroll
        for (int j = 0; j < 8; ++j) { const v2u w = r.y[j]; y[j] = (f32x4){bflo(w.x), bfhi(w.x), bflo(w.y), bfhi(w.y)};
            ss += (y[j][0] * y[j][0] + y[j][1] * y[j][1]) + (y[j][2] * y[j][2] + y[j][3] * y[j][3]); }
        const float rstd = rsq_f(wave_sum(ss) * (1.0f / DM) + NORM_EPS);
#pragma unroll
        for (int j = 0; j < 8; ++j) { const f32x4 va = *(const LAS f32x4*)(VA + lane * 4 + 256 * j); r.x[j] = r.x[j] + va * (y[j] * rstd); }
    }
    if (cfg.dst == 2) {
#pragma unroll
        for (int j = 0; j < 8; ++j) *(f32x4*)(xdst + lane * 4 + 256 * j) = r.x[j];
    } else if (cfg.dst == 1) {
#pragma unroll
        for (int j = 0; j < 8; ++j) { v2u o; o.x = cvtpk2(r.x[j][0], r.x[j][1]); o.y = cvtpk2(r.x[j][2], r.x[j][3]); *(v2u*)(xbdst + lane * 4 + 256 * j) = o;
            r.x[j] = (f32x4){bflo(o.x), bfhi(o.x), bflo(o.y), bfhi(o.y)}; }
    }
    if (cfg.has_h) {
        float ss = 0.f;
#pragma unroll
        for (int j = 0; j < 8; ++j) ss += (r.x[j][0] * r.x[j][0] + r.x[j][1] * r.x[j][1]) + (r.x[j][2] * r.x[j][2] + r.x[j][3] * r.x[j][3]);
        const float rstd = rsq_f(wave_sum(ss) * (1.0f / DM) + NORM_EPS);
#pragma unroll
        for (int j = 0; j < 8; ++j) { const f32x4 vb = *(const LAS f32x4*)(VB + lane * 4 + 256 * j), vc = *(const LAS f32x4*)(VC + lane * 4 + 256 * j);
            const f32x4 h = (r.x[j] * rstd) * vb + vc; v2u o; o.x = cvtpk2(h[0], h[1]); o.y = cvtpk2(h[2], h[3]);
            *(v2u*)(hdst + lane * 4 + 256 * j) = o; }
    }
}
__device__ __forceinline__ void phase_rows(Frame& F, const Args& a, const RowCfg cfg) {
    unsigned char* ws = F.ws;
    const float* MOD = (const float*)(ws + WS_MOD);
    bf16_t* X = (bf16_t*)(ws + WS_X); bf16_t* HA = (bf16_t*)(ws + WS_HA); const bf16_t* Y = (const bf16_t*)(ws + WS_Y);
    LAS float* V = (LAS float*)F.lds;
    for (int blk = F.bx; blk < 256; blk += F.G) {
        const int b = blk >> 6;
        RowRegs r0, r1;
        struct RowRaw { v2u x[8], y[8]; } w0, w1, w2, w3;
#define ROW_LD(RR, Q) do { const int li_ = blk * 64 + F.wave * 8 + (Q); const size_t row_ = (size_t)b * RB + (li_ & 4095); \
            row_load(RR, cfg.src_input ? a.in[IN_X] + (size_t)li_ * DM : nullptr, X + row_ * DM, Y + row_ * LDA2, F.lane, cfg.has_res); } while (0)
#define ROW_CP(RR, Q) do { const int li_ = blk * 64 + F.wave * 8 + (Q); const size_t row_ = (size_t)b * RB + (li_ & 4095); \
            row_compute(RR, a.out + (size_t)li_ * DM, X + row_ * DM, HA + row_ * LDA2, V, V + DM, V + 2 * DM, F.lane, cfg); } while (0)
#define RAW_LD(WW, Q) do { const int li_ = blk * 64 + F.wave * 8 + (Q); const size_t row_ = (size_t)b * RB + (li_ & 4095); \
                _Pragma("unroll") for (int j = 0; j < 8; ++j) { WW.x[j] = *(const v2u*)(X + row_ * DM + F.lane * 4 + 256 * j); WW.y[j] = *(const v2u*)(Y + row_ * LDA2 + F.lane * 4 + 256 * j); } } while (0)
#define RAW_CP(WW, Q) do { _Pragma("unroll") for (int j = 0; j < 8; ++j) { r0.x[j] = (f32x4){bflo(WW.x[j].x), bfhi(WW.x[j].x), bflo(WW.x[j].y), bfhi(WW.x[j].y)}; r0.y[j] = WW.y[j]; } ROW_CP(r0, Q); } while (0)
        const bool cx = cfg.do_ctx && F.wave < 4;
        const int ci = blk * 4 + F.wave; const size_t crow_ = (size_t)b * RB + SEQ + (ci & 255);
        RowRegs rc;
        if (cx) row_load(rc, cfg.src_input ? a.in[IN_CTX] + (size_t)ci * DM : nullptr, X + crow_ * DM, Y + crow_ * LDA2, F.lane, 0);
        if (cfg.src_input) { ROW_LD(r0, 0); } else { RAW_LD(w0, 0); RAW_LD(w1, 1); RAW_LD(w2, 2); }
        __syncthreads();
        for (int set = 0; set < (cfg.do_ctx ? 2 : 1); ++set) {
            const int mr = set ? 4 : b;
            for (int i = F.tid; i < DM; i += NTHREADS) {
                if (cfg.has_res) V[(set * 3 + 0) * DM + i] = MOD[(size_t)(cfg.l_res * 5 + mr) * NMOD + cfg.gate_idx * DM + i] * cfg.gpost[i];
                if (cfg.has_h) { V[(set * 3 + 1) * DM + i] = cfg.gpre[i] * (1.0f + MOD[(size_t)(cfg.l_h * 5 + mr) * NMOD + cfg.sc_idx * DM + i]);
                                 V[(set * 3 + 2) * DM + i] = MOD[(size_t)(cfg.l_h * 5 + mr) * NMOD + cfg.sh_idx * DM + i]; }
            }
        }
        __syncthreads();
        if (cx) {
            if (cfg.has_res) {
                const bf16_t* ys = (const bf16_t*)(ws + WS_YS) + (size_t)ci * LDA2 + F.lane * 4;
#pragma unroll
                for (int j = 0; j < 8; ++j) { f32x4 acc4 = (f32x4){0.f, 0.f, 0.f, 0.f};
#pragma unroll
                    for (int sl = 0; sl < 4; ++sl) { const v2u w = *(const v2u*)(ys + (size_t)sl * 1024 * LDA2 + 256 * j); acc4 = acc4 + (f32x4){bflo(w.x), bfhi(w.x), bflo(w.y), bfhi(w.y)}; }
                    rc.y[j].x = cvtpk2(acc4[0], acc4[1]); rc.y[j].y = cvtpk2(acc4[2], acc4[3]); } }
            row_compute(rc, nullptr, X + crow_ * DM, HA + crow_ * LDA2, V + 3 * DM, V + 4 * DM, V + 5 * DM, F.lane, cfg); }
        if (cfg.src_input) {
            for (int q = 0; q < 8; q += 2) {
                ROW_LD(r1, q + 1);
                ROW_CP(r0, q);
                if (q + 2 < 8) ROW_LD(r0, q + 2);
                ROW_CP(r1, q + 1);
            }
        } else {
            RAW_LD(w3, 3); RAW_CP(w0, 0);
            RAW_LD(w0, 4); RAW_CP(w1, 1);
            RAW_LD(w1, 5); RAW_CP(w2, 2);
            RAW_LD(w2, 6); RAW_CP(w3, 3);
            RAW_LD(w3, 7); RAW_CP(w0, 4);
            RAW_CP(w1, 5); RAW_CP(w2, 6); RAW_CP(w3, 7);
        }
#undef RAW_LD
#undef RAW_CP
#undef ROW_LD
#undef ROW_CP
    }
    __syncthreads();
}

__device__ __forceinline__ float half_sum32(float v, int lane) { v = row_sum16(v); const float lo = rl_f(v, 0) + rl_f(v, 16), hi = rl_f(v, 32) + rl_f(v, 48); return (lane & 32) ? hi : lo; }
struct HnRegs { v4u f[4], b[4], o[4]; };
__device__ __forceinline__ void hn_load(HnRegs& r, const bf16_t* HFp, const bf16_t* HBp, const bf16_t* PRJ, size_t row, int lane) {
#pragma unroll
    for (int j = 0; j < 4; ++j) { const int col = j * 512 + lane * 8;
        r.f[j] = *(const v4u*)(HFp + row * LDA2 + col); r.b[j] = *(const v4u*)(HBp + row * LDA2 + col); r.o[j] = *(const v4u*)(PRJ + row * PRJ_LD + 4096 + col); }
}
__device__ __forceinline__ void hn_compute(const HnRegs& r, bf16_t* HO, int ldo, const float* gh, size_t row, int lane) {
#pragma unroll
    for (int j = 0; j < 4; ++j) { const int col = j * 512 + lane * 8;
        float h[8]; float ss = 0.f;
#pragma unroll
        for (int e = 0; e < 4; ++e) { h[2 * e] = bflo(r.f[j][e]) + bflo(r.b[j][e]); h[2 * e + 1] = bfhi(r.f[j][e]) + bfhi(r.b[j][e]); ss += h[2 * e] * h[2 * e] + h[2 * e + 1] * h[2 * e + 1]; }
        const float rstd = 1.0f / sqrtf(half_sum32(ss, lane) * (1.0f / 256.0f) + NORM_EPS);
        const f32x4 g0 = *(const f32x4*)(gh + col), g1 = *(const f32x4*)(gh + col + 4);
        v4u w;
#pragma unroll
        for (int e = 0; e < 4; ++e) { const float ga = (e < 2) ? g0[2 * e] : g1[2 * e - 4], gb = (e < 2) ? g0[2 * e + 1] : g1[2 * e - 3];
            w[e] = cvtpk2(h[2 * e] * rstd * ga * bflo(r.o[j][e]), h[2 * e + 1] * rstd * gb * bfhi(r.o[j][e])); }
        *(v4u*)(HO + row * ldo + col) = w; }
}
__device__ __forceinline__ void phase_headnorm_ctx(Frame& F, const Args& a, bf16_t* HO, int ldo) {
    unsigned char* ws = F.ws;
    const bf16_t* HFp = (const bf16_t*)(ws + WS_HF); const bf16_t* HBp = (const bf16_t*)(ws + WS_HB); const bf16_t* PRJ = (const bf16_t*)(ws + WS_PRJ);
    const float* gh = a.in[IN_GHEAD];
    const int gw = F.bx * NWAVES + F.wave, NGW = F.G * NWAVES;
    for (int ci = gw; ci < BATCH * CTXL; ci += NGW) {
        const size_t row = (size_t)(ci >> 8) * RB + SEQ + (ci & 255);
        HnRegs r0;
        hn_load(r0, HFp, HBp, PRJ, row, F.lane);
        hn_compute(r0, HO, ldo, gh, row, F.lane);
    }
    __syncthreads();
}

__device__ __forceinline__ float sum16(float v) { return row_sum16(v); }
struct QkRegs { v4u q[4]; v4u k; };
__device__ __forceinline__ void qk_load(QkRegs& r, const bf16_t* Q1, const bf16_t* K1, size_t row, int lane, bool lat) {
    const int hg = lane >> 4, e0 = (lane & 15) * 8;
    if (lat) {
#pragma unroll
        for (int j = 0; j < 4; ++j) r.q[j] = *(const v4u*)(Q1 + row * LDA2 + (4 * j + hg) * 128 + e0);
    }
    r.k = *(const v4u*)(K1 + row * LDKV + hg * 128 + e0);
}
__device__ __forceinline__ v4u qk_norm_rope(const v4u w, const float (&g)[8], const float (&cs)[4], const float (&sn)[4]) {
    float x[8]; float ss = 0.f;
#pragma unroll
    for (int e = 0; e < 4; ++e) { x[2 * e] = bflo(w[e]); x[2 * e + 1] = bfhi(w[e]); ss += x[2 * e] * x[2 * e] + x[2 * e + 1] * x[2 * e + 1]; }
    const float rstd = 1.0f / sqrtf(sum16(ss) * (1.0f / 128.0f) + NORM_EPS);
    v4u o;
#pragma unroll
    for (int e = 0; e < 4; ++e) { const float x0 = x[2 * e] * rstd * g[2 * e], x1 = x[2 * e + 1] * rstd * g[2 * e + 1];
        o[e] = cvtpk2(x0 * cs[e] - x1 * sn[e], x0 * sn[e] + x1 * cs[e]); }
    return o;
}
__device__ __forceinline__ void qk_compute(const QkRegs& r, bf16_t* Q1, bf16_t* K1, size_t row, int lane, bool lat, int t, const LAS float* tab, const float (&gq)[8], const float (&gk)[8]) {
    const int hg = lane >> 4, e0 = (lane & 15) * 8;
    float cs[4], sn[4];
#pragma unroll
    for (int p = 0; p < 4; ++p) { cs[p] = 1.f; sn[p] = 0.f; }
    if (lat) {
        const int i0 = e0 >> 1; const int pos = (i0 < 32) ? (t >> 6) : (t & 63); const int f0 = i0 & 31;
#pragma unroll
        for (int p = 0; p < 4; ++p) { cs[p] = tab[(pos * 32 + f0 + p) * 2]; sn[p] = tab[(pos * 32 + f0 + p) * 2 + 1]; }
#pragma unroll
        for (int j = 0; j < 4; ++j) *(v4u*)(Q1 + row * LDA2 + (4 * j + hg) * 128 + e0) = qk_norm_rope(r.q[j], gq, cs, sn);
    }
    *(v4u*)(K1 + row * LDKV + hg * 128 + e0) = qk_norm_rope(r.k, gk, cs, sn);
}
__device__ __forceinline__ void phase_qknorm(Frame& F, const Args& a) {
    unsigned char* ws = F.ws;
    bf16_t* Q1 = (bf16_t*)(ws + WS_Q1); bf16_t* K1 = (bf16_t*)(ws + WS_K1);
    float gq[8], gk[8];
    { const int e0 = (F.lane & 15) * 8;
#pragma unroll
      for (int e = 0; e < 8; ++e) { gq[e] = a.in[IN_GQ][e0 + e]; gk[e] = a.in[IN_GK][e0 + e]; } }
    const int gw = F.bx * NWAVES + F.wave, NGW = F.G * NWAVES;
    for (int ci = gw; ci < BATCH * CTXL; ci += NGW) {
        const bf16_t* qs = (const bf16_t*)(ws + WS_QS) + (size_t)ci * 1024 + F.lane * 8;
        float ka[8], va[8];
#pragma unroll
        for (int e = 0; e < 8; ++e) { ka[e] = 0.f; va[e] = 0.f; }
#pragma unroll
        for (int sl = 0; sl < 8; ++sl) { const v4u wk = *(const v4u*)(qs + (size_t)sl * 1024 * 1024), wv = *(const v4u*)(qs + (size_t)sl * 1024 * 1024 + 512);
#pragma unroll
            for (int e = 0; e < 4; ++e) { ka[2 * e] += bflo(wk[e]); ka[2 * e + 1] += bfhi(wk[e]); va[2 * e] += bflo(wv[e]); va[2 * e + 1] += bfhi(wv[e]); } }
        float ss = 0.f;
#pragma unroll
        for (int e = 0; e < 8; ++e) ss += ka[e] * ka[e];
        const float rstd = 1.0f / sqrtf(sum16(ss) * (1.0f / 128.0f) + NORM_EPS);
        const size_t row = (size_t)(ci >> 8) * RB + SEQ + (ci & 255);
        v4u ok, ov;
#pragma unroll
        for (int e = 0; e < 4; ++e) { ok[e] = cvtpk2(ka[2 * e] * rstd * gk[2 * e], ka[2 * e + 1] * rstd * gk[2 * e + 1]); ov[e] = cvtpk2(va[2 * e], va[2 * e + 1]); }
        *(v4u*)(K1 + row * LDKV + F.lane * 8) = ok; *(v4u*)((bf16_t*)(ws + WS_V1) + row * LDKV + F.lane * 8) = ov;
    }
    __syncthreads();
}

__device__ __forceinline__ void phase_scan_naive(Frame& F, const Args& a) {
    unsigned char* ws = F.ws;
    const bf16_t* PRJ = (const bf16_t*)(ws + WS_PRJ); const float* GATES = (const float*)(ws + WS_GATES);
    LAS float* Qs = (LAS float*)F.lds;
    LAS float* Ks = Qs + 64 * 129;
    LAS float* Vs = Ks + 64 * 129;
    LAS float* Ps = Vs + 64 * 65;
    LAS float* Cs = Ps + 64 * 65;
    LAS float* ns = Cs + 128 * 65;
    LAS float* gs = ns + 128;
    const int tid = F.tid;
    for (int item = F.bx; item < 256; item += F.G) {
        const int vs = item & 3, dir = (item >> 2) & 1, hh = (item >> 3) & 7, b = item >> 6;
        bf16_t* HO = (bf16_t*)(ws + (dir ? WS_HB : WS_HF));
        __syncthreads();
        for (int i = tid; i < 128 * 65; i += NTHREADS) Cs[i] = 0.f;
        if (tid < 128) ns[tid] = 0.f;
        float mprev = 0.f;
        for (int step = 0; step < 68; ++step) {
            const bool isctx = step < 4; const int cj = isctx ? (dir ? 3 - step : step) : (dir ? 63 - (step - 4) : step - 4);
            const size_t rbase = (size_t)b * RB + (isctx ? SEQ : 0) + 64 * cj;
            __syncthreads();
            for (int i = tid; i < 64 * 64; i += NTHREADS) { const int p = i >> 6, c2 = i & 63; const size_t row = rbase + (dir ? 63 - p : p);
                const unsigned wq = *(const unsigned*)(PRJ + row * PRJ_LD + hh * 128 + 2 * c2), wk = *(const unsigned*)(PRJ + row * PRJ_LD + 1024 + hh * 128 + 2 * c2);
                Qs[p * 129 + 2 * c2] = bflo(wq); Qs[p * 129 + 2 * c2 + 1] = bfhi(wq); Ks[p * 129 + 2 * c2] = bflo(wk); Ks[p * 129 + 2 * c2 + 1] = bfhi(wk); }
            for (int i = tid; i < 64 * 32; i += NTHREADS) { const int p = i >> 5, c2 = i & 31; const size_t row = rbase + (dir ? 63 - p : p);
                const unsigned wv = *(const unsigned*)(PRJ + row * PRJ_LD + 2048 + hh * 256 + vs * 64 + 2 * c2);
                Vs[p * 65 + 2 * c2] = bflo(wv); Vs[p * 65 + 2 * c2 + 1] = bfhi(wv); }
            if (tid < 64) { const size_t row = rbase + (dir ? 63 - tid : tid); gs[tid] = GATES[row * 32 + dir * 16 + hh]; gs[64 + tid] = GATES[row * 32 + dir * 16 + 8 + hh]; }
            __syncthreads();
            if (tid < 64) {
                float bc = 0.f; for (int r = 0; r <= tid; ++r) bc += gs[64 + r];
                gs[128 + tid] = bc; gs[192 + tid] = gs[tid] - bc;
            }
            __syncthreads();
            if (tid < 64) {
                float amax = -3.0e38f; for (int s = 0; s <= tid; ++s) amax = fmaxf(amax, gs[192 + s]);
                const float bc = gs[128 + tid];
                const float mt = fmaxf(bc + mprev, bc + amax);
                gs[256 + tid] = mt; gs[320 + tid] = expf(bc + mprev - mt);
            }
            float bend, mnew, decay;
            {
                bend = gs[128 + 63]; float amax = -3.0e38f; for (int s = 0; s < 64; ++s) amax = fmaxf(amax, gs[192 + s]);
                mnew = fmaxf(bend + mprev, bend + amax); decay = expf(bend + mprev - mnew);
            }
            if (tid < 64) gs[384 + tid] = expf(bend + gs[192 + tid] - mnew);
            __syncthreads();
            {
                const int t = tid >> 3, s0 = (tid & 7) * 8; float acc[8];
#pragma unroll
                for (int j = 0; j < 8; ++j) acc[j] = 0.f;
                for (int d = 0; d < 128; ++d) { const float qv = Qs[t * 129 + d];
#pragma unroll
                    for (int j = 0; j < 8; ++j) acc[j] += qv * Ks[(s0 + j) * 129 + d]; }
                const float bt = gs[128 + t], mt = gs[256 + t];
#pragma unroll
                for (int j = 0; j < 8; ++j) { const int s = s0 + j; Ps[t * 65 + s] = (s <= t) ? acc[j] * expf(bt + gs[192 + s] - mt) : 0.f; }
            }
            __syncthreads();
            {
                const int t = tid >> 3, v0 = (tid & 7) * 8; float num[8], c2[8]; float den = 0.f, qn = 0.f;
#pragma unroll
                for (int j = 0; j < 8; ++j) { num[j] = 0.f; c2[j] = 0.f; }
                for (int s = 0; s < 64; ++s) { const float pv = Ps[t * 65 + s]; den += pv;
#pragma unroll
                    for (int j = 0; j < 8; ++j) num[j] += pv * Vs[s * 65 + v0 + j]; }
                for (int d = 0; d < 128; ++d) { const float qv = Qs[t * 129 + d]; qn += qv * ns[d];
#pragma unroll
                    for (int j = 0; j < 8; ++j) c2[j] += qv * Cs[d * 65 + v0 + j]; }
                const float inter = gs[320 + t], mt = gs[256 + t];
                den += inter * qn;
                const float dn = 1.0f / fmaxf(fabsf(den), expf(-mt));
                const size_t row = rbase + (dir ? 63 - t : t);
                v4u o; float hv[8];
#pragma unroll
                for (int j = 0; j < 8; ++j) hv[j] = (num[j] + inter * c2[j]) * dn;
                o.x = pk2(hv[0], hv[1]); o.y = pk2(hv[2], hv[3]); o.z = pk2(hv[4], hv[5]); o.w = pk2(hv[6], hv[7]);
                *(v4u*)(HO + row * LDA2 + hh * 256 + vs * 64 + v0) = o;
            }
            __syncthreads();
            {
                const int d = tid >> 2, v0 = (tid & 3) * 16; float acc[16]; float nacc = 0.f;
#pragma unroll
                for (int j = 0; j < 16; ++j) acc[j] = 0.f;
                for (int s = 0; s < 64; ++s) { const float kw = gs[384 + s] * Ks[s * 129 + d]; nacc += kw;
#pragma unroll
                    for (int j = 0; j < 16; ++j) acc[j] += kw * Vs[s * 65 + v0 + j]; }
#pragma unroll
                for (int j = 0; j < 16; ++j) Cs[d * 65 + v0 + j] = decay * Cs[d * 65 + v0 + j] + acc[j];
                if ((tid & 3) == 0) ns[d] = decay * ns[d] + nacc;
            }
            mprev = mnew;
        }
    }
    __syncthreads();
}

typedef short sbf16x8 __attribute__((ext_vector_type(8)));
typedef float sf32x16 __attribute__((ext_vector_type(16)));
#define MFMA32(a, b, c) __builtin_amdgcn_mfma_f32_32x32x16_bf16((a), (b), (c), 0, 0, 0)
constexpr int SC_QP = 272, SC_TP = 144, SC_CP = 272;
constexpr int SC_Q = 0, SC_K = SC_Q + 64 * SC_QP, SC_KT = SC_K + 64 * SC_QP, SC_VT = SC_KT + 2 * 128 * SC_TP, SC_CT = SC_VT + 2 * 64 * SC_TP, SC_P = SC_CT + 96 * SC_CP, SC_PS = SC_P + 64 * SC_TP, SC_GS = SC_PS + 512, SC_END = SC_GS + 8 * 1280;
static_assert(SC_END <= MISC_OFF, "scan LDS");
__device__ __forceinline__ unsigned pk_lo(unsigned a, unsigned b) { return (a & 0xffffu) | (b << 16); }
__device__ __forceinline__ unsigned pk_hi(unsigned a, unsigned b) { return (a >> 16) | (b & 0xffff0000u); }
#define SC_LBAR() do { asm volatile("s_waitcnt lgkmcnt(0)" ::: "memory"); __builtin_amdgcn_s_barrier(); asm volatile("" ::: "memory"); } while (0)

struct ScStage { v4u q0, q1, k0, k1, v0; float gi, gf; };
struct ScGate { float bc, av, am, bend, amall; };
struct ScCtx { const bf16_t* PRJ; const float* GATES; bf16_t* HO; LAS unsigned char* lds; LAS float* g; int b, hh, vs, dir, lane, wave, r, h, grow, sgn; unsigned okm; };

__device__ __forceinline__ size_t sc_rbase(const ScCtx& c, int st) { return (size_t)c.b * RB + ((st < 4) ? (SEQ + 64 * (c.dir ? 3 - st : st)) : 64 * (c.dir ? 63 - (st - 4) : st - 4)); }
__device__ __forceinline__ void sc_load(const ScCtx& c, int st, ScStage& s) {
    const size_t rb = sc_rbase(c, st); const int row = 8 * c.wave + (c.lane >> 3), ch = c.lane & 7;
    const bf16_t* p0 = c.PRJ + (rb + row) * PRJ_LD + c.hh * 128 + ch * 8;
    s.q0 = *(const v4u*)p0; s.q1 = *(const v4u*)(p0 + 64); s.k0 = *(const v4u*)(p0 + 1024); s.k1 = *(const v4u*)(p0 + 1024 + 64);
    s.v0 = *(const v4u*)(c.PRJ + (rb + row) * PRJ_LD + 2048 + c.hh * 256 + c.vs * 64 + ch * 8);
    s.gi = c.GATES[(rb + c.grow) * 32 + c.dir * 16 + c.hh]; s.gf = c.GATES[(rb + c.grow) * 32 + c.dir * 16 + 8 + c.hh];
}
__device__ __forceinline__ int sc_troff(int trow, int kchunk) { return trow * SC_TP + ((kchunk ^ ((trow >> 3) & 7)) << 4); }
template <int CTRL> __device__ __forceinline__ unsigned sc_dppu(unsigned old, unsigned src) { return (unsigned)__builtin_amdgcn_update_dpp((int)old, (int)src, CTRL, 0xf, 0xf, false); }
__device__ __forceinline__ void sc_tr_write(LAS unsigned char* T, const v4u w, int row, int c0, int lane) {
    const bool hi = (lane >> 3) & 1;
    unsigned r0 = sc_dppu<0x108>(0u, w[0]), r1 = sc_dppu<0x108>(0u, w[1]);
    r0 = sc_dppu<0x118>(r0, w[2]); r1 = sc_dppu<0x118>(r1, w[3]);
    const unsigned a0 = hi ? r0 : w[0], a1 = hi ? r1 : w[1], b0 = hi ? w[2] : r0, b1 = hi ? w[3] : r1;
    LAS unsigned char* p = T + (c0 + (hi ? 4 : 0)) * SC_TP + ((((row >> 3) ^ (c0 >> 3)) & 7) << 4) + 2 * (row & 6);
    *(LAS unsigned*)(p) = pk_lo(a0, b0); *(LAS unsigned*)(p + SC_TP) = pk_hi(a0, b0); *(LAS unsigned*)(p + 2 * SC_TP) = pk_lo(a1, b1); *(LAS unsigned*)(p + 3 * SC_TP) = pk_hi(a1, b1);
}
__device__ __forceinline__ void sc_write(const ScCtx& c, const ScStage& s, int buf) {
    LAS unsigned char* lds = c.lds; const int row = 8 * c.wave + (c.lane >> 3), ch = c.lane & 7;
    *(LAS v4u*)(lds + SC_Q + row * SC_QP + ch * 16) = s.q0; *(LAS v4u*)(lds + SC_Q + row * SC_QP + (ch + 8) * 16) = s.q1;
    *(LAS v4u*)(lds + SC_K + row * SC_QP + ch * 16) = s.k0; *(LAS v4u*)(lds + SC_K + row * SC_QP + (ch + 8) * 16) = s.k1;
    LAS unsigned char* kt = lds + SC_KT + buf * 128 * SC_TP; LAS unsigned char* vt = lds + SC_VT + buf * 64 * SC_TP;
    sc_tr_write(kt, s.k0, row, ch * 8, c.lane); sc_tr_write(kt, s.k1, row, 64 + ch * 8, c.lane); sc_tr_write(vt, s.v0, row, ch * 8, c.lane);
}
template <int CTRL, int ROWMASK> __device__ __forceinline__ float sc_dpp(float old, float src) {
    return __builtin_bit_cast(float, __builtin_amdgcn_update_dpp(__builtin_bit_cast(int, old), __builtin_bit_cast(int, src), CTRL, ROWMASK, 0xf, false)); }
__device__ __forceinline__ void sc_gate(const ScCtx& c, float gi, float gf, ScGate& o) {
    float bc = gf;
    bc += sc_dpp<0x111, 0xf>(0.f, bc); bc += sc_dpp<0x112, 0xf>(0.f, bc); bc += sc_dpp<0x114, 0xf>(0.f, bc); bc += sc_dpp<0x118, 0xf>(0.f, bc);
    bc += sc_dpp<0x142, 0xa>(0.f, bc); bc += sc_dpp<0x143, 0xc>(0.f, bc);
    const float av = gi - bc;
    const float NI = -3.0e38f;
    float am = av;
    am = fmaxf(am, sc_dpp<0x111, 0xf>(NI, am)); am = fmaxf(am, sc_dpp<0x112, 0xf>(NI, am)); am = fmaxf(am, sc_dpp<0x114, 0xf>(NI, am)); am = fmaxf(am, sc_dpp<0x118, 0xf>(NI, am));
    am = fmaxf(am, sc_dpp<0x142, 0xa>(NI, am)); am = fmaxf(am, sc_dpp<0x143, 0xc>(NI, am));
    o.bc = bc; o.av = av; o.am = am;
    o.bend = __builtin_bit_cast(float, __builtin_amdgcn_readlane(__builtin_bit_cast(int, bc), 63)); o.amall = __builtin_bit_cast(float, __builtin_amdgcn_readlane(__builtin_bit_cast(int, am), 63));
}
__device__ __forceinline__ void sc_table(const ScCtx& c, const ScGate& cur, float& mprev, int par) {
    LAS float* g = c.g + par * 384;
    const float mt = cur.bc + fmaxf(mprev, cur.am);
    const float mnew = cur.bend + fmaxf(mprev, cur.amall), decay = __expf(cur.bend + mprev - mnew);
    const int gr = c.grow;
    g[gr] = cur.av; g[64 + gr] = cur.bc - mt; g[128 + gr] = __expf(cur.bc + mprev - mt); g[192 + gr] = __expf(-mt); g[256 + gr] = __expf(cur.bend + cur.av - mnew);
    if (c.lane == 0) g[320] = decay;
    mprev = mnew;
}
template <int V> __device__ __forceinline__ void sc_step(const ScCtx& c, int step, ScStage& ld, const ScStage& wr, ScGate& cur, float& mprev, sf32x16 (&accC)[3]) {
    LAS unsigned char* lds = c.lds; LAS float* g = c.g + (step & 1) * 384;
    const int wave = c.wave, r = c.r, h = c.h, buf = step & 1;
    const size_t rbase = sc_rbase(c, step);
    if (V == 0 || V == 4) sc_load(c, step + 2 < 68 ? step + 2 : 67, ld);
    LAS unsigned char* kt = lds + SC_KT + buf * 128 * SC_TP; LAS unsigned char* vt = lds + SC_VT + buf * 64 * SC_TP;
    if (V < 2 && wave >= 4) {
        const int sb = (wave - 4) >> 1, tb = (wave - 4) & 1, t = 32 * tb + r;
        sf32x16 x0, x1;
#pragma unroll
        for (int i = 0; i < 16; ++i) { x0[i] = 0.f; x1[i] = 0.f; }
        const bool live = c.sgn * (sb - tb) <= 0;
        const float bm_t = g[64 + t];
        if (live) {
#pragma unroll
            for (int kh = 0; kh < 8; kh += 4) {
                sbf16x8 kfr[4], qfr[4];
#pragma unroll
                for (int k2 = 0; k2 < 4; ++k2) { const int ks = kh + k2; kfr[k2] = *(const LAS sbf16x8*)(lds + SC_K + (32 * sb + r) * SC_QP + (16 * ks + 8 * h) * 2); qfr[k2] = *(const LAS sbf16x8*)(lds + SC_Q + t * SC_QP + (16 * ks + 8 * h) * 2); }
                __builtin_amdgcn_sched_barrier(0);
                x0 = MFMA32(kfr[0], qfr[0], x0); x1 = MFMA32(kfr[1], qfr[1], x1); x0 = MFMA32(kfr[2], qfr[2], x0); x1 = MFMA32(kfr[3], qfr[3], x1);
            }
        }
        float psum = 0.f;
#pragma unroll
        for (int gq = 0; gq < 4; ++gq) {
            const f32x4 a4 = *(const LAS f32x4*)(g + 32 * sb + 8 * gq + 4 * h);
            float p[4];
#pragma unroll
            for (int i = 0; i < 4; ++i) { const bool ok = (c.okm >> (4 * gq + i)) & 1u; p[i] = ok ? (x0[4 * gq + i] + x1[4 * gq + i]) * __expf(bm_t + a4[i]) : 0.f; psum += p[i]; }
            v2u w; w.x = cvtpk2(p[0], p[1]); w.y = cvtpk2(p[2], p[3]);
            *(LAS v2u*)(lds + SC_P + t * SC_TP + (32 * sb + 8 * gq + 4 * h) * 2) = w;
        }
        psum += __shfl_xor(psum, 32);
        if (h == 0) *(LAS float*)(lds + SC_PS + (sb * 64 + t) * 4) = psum;
    }
    sf32x16 (&aq) = accC[0]; sf32x16 (&ad) = accC[1];
    const int otb = wave >> 1, ovb = wave & 1, ot = 32 * otb + r;
    if (V < 2 && wave < 4) {
#pragma unroll
        for (int i = 0; i < 16; ++i) { aq[i] = 0.f; ad[i] = 0.f; }
#pragma unroll
        for (int kh = 0; kh < 8; kh += 4) {
            sbf16x8 qf[4], cf[4], nf[4];
#pragma unroll
            for (int k2 = 0; k2 < 4; ++k2) { const int ks = kh + k2;
                qf[k2] = *(const LAS sbf16x8*)(lds + SC_Q + ot * SC_QP + (16 * ks + 8 * h) * 2);
                cf[k2] = *(const LAS sbf16x8*)(lds + SC_CT + (32 * ovb + r) * SC_CP + (16 * ks + 8 * h) * 2);
                nf[k2] = *(const LAS sbf16x8*)(lds + SC_CT + (64 + r) * SC_CP + (16 * ks + 8 * h) * 2); }
            __builtin_amdgcn_sched_barrier(0);
#pragma unroll
            for (int k2 = 0; k2 < 4; ++k2) { aq = MFMA32(cf[k2], qf[k2], aq); ad = MFMA32(nf[k2], qf[k2], ad); }
        }
    }
    SC_LBAR();
    if (V >= 2) {} else if (wave >= 4) {
        const int db = wave - 4;
        { const float decay = g[320];
#pragma unroll
        for (int n = 0; n < 3; ++n) accC[n] = accC[n] * decay; }
        const sbf16x8 onesf = (r == 0) ? (sbf16x8){0x3F80, 0x3F80, 0x3F80, 0x3F80, 0x3F80, 0x3F80, 0x3F80, 0x3F80} : (sbf16x8){0, 0, 0, 0, 0, 0, 0, 0};
#pragma unroll
        for (int kh = 0; kh < 4; kh += 2) {
        sbf16x8 kfa[2], v0a[2], v1a[2]; f32x4 w0a[2], w1a[2];
#pragma unroll
        for (int k2 = 0; k2 < 2; ++k2) { const int ks = kh + k2; kfa[k2] = *(const LAS sbf16x8*)(kt + sc_troff(32 * db + r, 2 * ks + h));
            w0a[k2] = *(const LAS f32x4*)(g + 256 + 16 * ks + 8 * h); w1a[k2] = *(const LAS f32x4*)(g + 256 + 16 * ks + 8 * h + 4);
            v0a[k2] = *(const LAS sbf16x8*)(vt + sc_troff(r, 2 * ks + h)); v1a[k2] = *(const LAS sbf16x8*)(vt + sc_troff(32 + r, 2 * ks + h)); }
        __builtin_amdgcn_sched_barrier(0);
#pragma unroll
        for (int k2 = 0; k2 < 2; ++k2) {
            const sbf16x8 kf = kfa[k2];
            const f32x4 w0 = w0a[k2], w1 = w1a[k2];
            v4u kw;
            kw.x = cvtpk2(bf2f((unsigned short)kf[0]) * w0[0], bf2f((unsigned short)kf[1]) * w0[1]); kw.y = cvtpk2(bf2f((unsigned short)kf[2]) * w0[2], bf2f((unsigned short)kf[3]) * w0[3]);
            kw.z = cvtpk2(bf2f((unsigned short)kf[4]) * w1[0], bf2f((unsigned short)kf[5]) * w1[1]); kw.w = cvtpk2(bf2f((unsigned short)kf[6]) * w1[2], bf2f((unsigned short)kf[7]) * w1[3]);
            const sbf16x8 kwf = __builtin_bit_cast(sbf16x8, kw);
            const sbf16x8 v0f = v0a[k2], v1f = v1a[k2];
            accC[0] = MFMA32(kwf, v0f, accC[0]); accC[1] = MFMA32(kwf, v1f, accC[1]); accC[2] = MFMA32(kwf, onesf, accC[2]);
        }
        }
#pragma unroll
        for (int n = 0; n < 3; ++n)
#pragma unroll
            for (int gq = 0; gq < 4; ++gq) { v2u w; w.x = cvtpk2(accC[n][4 * gq], accC[n][4 * gq + 1]); w.y = cvtpk2(accC[n][4 * gq + 2], accC[n][4 * gq + 3]);
                *(LAS v2u*)(lds + SC_CT + (32 * n + r) * SC_CP + (32 * db + 8 * gq + 4 * h) * 2) = w; }
    } else {
        sf32x16 (&an) = accC[2];
#pragma unroll
        for (int i = 0; i < 16; ++i) an[i] = 0.f;
        sbf16x8 vfa[4], pfa[4];
#pragma unroll
        for (int ks = 0; ks < 4; ++ks) { vfa[ks] = *(const LAS sbf16x8*)(vt + sc_troff(32 * ovb + r, 2 * ks + h)); pfa[ks] = *(const LAS sbf16x8*)(lds + SC_P + ot * SC_TP + (16 * ks + 8 * h) * 2); }
        const float inter_t = g[128 + ot], enm_t = g[192 + ot];
        const float ps = *(const LAS float*)(lds + SC_PS + ot * 4) + *(const LAS float*)(lds + SC_PS + (64 + ot) * 4);
        __builtin_amdgcn_sched_barrier(0);
#pragma unroll
        for (int ks = 0; ks < 4; ++ks) an = MFMA32(vfa[ks], pfa[ks], an);
        const float dq = __shfl(ad[0], r);
        const float den = ps + inter_t * dq;
        const float dn = rcp_f(fmaxf(fabsf(den), enm_t));
        bf16_t* op = c.HO + (rbase + ot) * LDA2 + c.hh * 256 + c.vs * 64 + 32 * ovb + 4 * h;
#pragma unroll
        for (int gq = 0; gq < 4; ++gq) { float o[4];
#pragma unroll
            for (int i = 0; i < 4; ++i) o[i] = (an[4 * gq + i] + inter_t * aq[4 * gq + i]) * dn;
            v2u w; w.x = cvtpk2(o[0], o[1]); w.y = cvtpk2(o[2], o[3]);
            if (V == 0 || V == 5) asm volatile("global_store_dwordx2 %0, %1, off" :: "v"(op + 8 * gq), "v"(w) : "memory"); else asm volatile("" :: "v"(w)); }
    }
    if (V < 3 && step + 1 < 68) {
        if (wave == 0) { ScGate nxt; sc_gate(c, wr.gi, wr.gf, nxt); cur = nxt; sc_table(c, cur, mprev, (step + 1) & 1); }
        sc_write(c, wr, buf ^ 1); }
    SC_LBAR();
}

template <int V> __device__ __forceinline__ void phase_scan_mfma(Frame& F) {
    unsigned char* ws = F.ws;
    ScCtx c; c.PRJ = (const bf16_t*)(ws + WS_PRJ); c.GATES = (const float*)(ws + WS_GATES); c.lds = F.lds;
    c.lane = F.lane; c.wave = F.wave; c.r = F.lane & 31; c.h = F.lane >> 5;
    c.g = (LAS float*)(F.lds + SC_GS);
    LAS unsigned char* lds = F.lds; const int tid = F.tid;
    for (int it0 = F.bx; it0 < 256; it0 += F.G) {
        const int item = (F.G == 256) ? ((it0 & 7) * 32 + (it0 >> 3)) : it0;
        c.vs = item & 3; c.dir = (item >> 2) & 1; c.hh = (item >> 3) & 7; c.b = item >> 6;
        c.HO = (bf16_t*)(ws + (c.dir ? WS_HB : WS_HF));
        c.grow = c.dir ? 63 - c.lane : c.lane; c.sgn = c.dir ? -1 : 1;
        c.okm = 0u;
        if (F.wave >= 4) { const int sb = (F.wave - 4) >> 1, tb = (F.wave - 4) & 1, t = 32 * tb + c.r;
#pragma unroll
            for (int k = 0; k < 16; ++k) { const int sr_ = 32 * sb + 8 * (k >> 2) + 4 * c.h + (k & 3); if (c.sgn * (sr_ - t) <= 0) c.okm |= 1u << k; } }
        __syncthreads();
        for (int i = tid; i < 96 * SC_CP / 16; i += NTHREADS) *(LAS v4u*)(lds + SC_CT + i * 16) = (v4u){0u, 0u, 0u, 0u};
        sf32x16 accC[3];
#pragma unroll
        for (int n = 0; n < 3; ++n)
#pragma unroll
            for (int i = 0; i < 16; ++i) accC[n][i] = 0.f;
        float mprev = 0.f;
        ScStage SA, SB;
        ScGate cur;
        sc_load(c, 0, SA); sc_load(c, 1, SB);
        sc_write(c, SA, 0);
        if (F.wave == 0) { sc_gate(c, SA.gi, SA.gf, cur); sc_table(c, cur, mprev, 0); }
        __syncthreads();
        for (int step = 0; step < 68; step += 2) {
            sc_step<V>(c, step, SA, SB, cur, mprev, accC);
            sc_step<V>(c, step + 1, SB, SA, cur, mprev, accC);
        }
    }
    __syncthreads();
}
namespace att2 {
typedef short bf16x8 __attribute__((ext_vector_type(8)));
typedef short s16x4 __attribute__((ext_vector_type(4)));
constexpr int KP = 272, TP = 136, KBUF = 64 * KP, VBUF = 128 * TP, A2_K = 0, A2_V = 2 * KBUF, A2_BYTES = 2 * KBUF + 3 * VBUF;
constexpr float SCALE = 0.088388347648318440f, THR = 8.f, CL2 = SCALE * 1.4426950408889634f;
constexpr int LDQ = LDA2, LDK = LDKV, LDO = LDA2;
#define A2_MFMA(a, b, c) __builtin_amdgcn_mfma_f32_16x16x32_bf16((a), (b), (c), 0, 0, 0)
struct Stg { v4u k0, k1, v0, v1; };
__device__ __forceinline__ float xmax4(float v) { v = fmaxf(v, __shfl_xor(v, 16)); v = fmaxf(v, __shfl_xor(v, 32)); return v; }
__device__ __forceinline__ float xsum4(float v) { v += __shfl_xor(v, 16); v += __shfl_xor(v, 32); return v; }
__device__ __forceinline__ void tr_write(LAS unsigned char* T, const v4u w, int row, int c0, int lane) {
    const bool hi = (lane >> 3) & 1;
    unsigned r0 = sc_dppu<0x108>(0u, w[0]), r1 = sc_dppu<0x108>(0u, w[1]);
    r0 = sc_dppu<0x118>(r0, w[2]); r1 = sc_dppu<0x118>(r1, w[3]);
    const unsigned a0 = hi ? r0 : w[0], a1 = hi ? r1 : w[1], b0 = hi ? w[2] : r0, b1 = hi ? w[3] : r1;
    LAS unsigned char* p = T + (c0 + (hi ? 4 : 0)) * TP + 2 * (row & ~1);
    *(LAS unsigned*)(p) = pk_lo(a0, b0); *(LAS unsigned*)(p + TP) = pk_hi(a0, b0); *(LAS unsigned*)(p + 2 * TP) = pk_lo(a1, b1); *(LAS unsigned*)(p + 3 * TP) = pk_hi(a1, b1);
}
__device__ __forceinline__ void sload(Stg& s, const bf16_t* Kh, const bf16_t* Vh, int key0, int wave, int lane) {
    const int row = 8 * wave + (lane >> 3), ch = lane & 7;
    const bf16_t* pk = Kh + (size_t)(key0 + row) * LDK + ch * 8; const bf16_t* pv = Vh + (size_t)(key0 + row) * LDK + ch * 8;
    s.k0 = *(const v4u*)pk; s.k1 = *(const v4u*)(pk + 64); s.v0 = *(const v4u*)pv; s.v1 = *(const v4u*)(pv + 64);
}
__device__ __forceinline__ void swrite(const Stg& s, LAS unsigned char* lds, int kbuf, int voff, int wave, int lane) {
    const int row = 8 * wave + (lane >> 3), ch = lane & 7;
    LAS unsigned char* kb = lds + A2_K + kbuf * KBUF; LAS unsigned char* vb = lds + A2_V + voff;
    *(LAS v4u*)(kb + row * KP + ch * 16) = s.k0; *(LAS v4u*)(kb + row * KP + (ch + 8) * 16) = s.k1;
    tr_write(vb, s.v0, row, ch * 8, lane); tr_write(vb, s.v1, row, 64 + ch * 8, lane);
}
__device__ __forceinline__ void qkt(f32x4 (&s)[2][4], const LAS unsigned char* kb, const bf16x8 (&qf)[2][4], int fr, int fq) {
    const LAS unsigned char* rp = kb + fr * KP + fq * 16;
    bf16x8 kf[2][4];
#pragma unroll
    for (int ks = 0; ks < 4; ++ks) kf[0][ks] = *(const LAS bf16x8*)(rp + ks * 64);
#pragma unroll
    for (int kt = 0; kt < 4; ++kt) {
        if (kt + 1 < 4) {
#pragma unroll
            for (int ks = 0; ks < 4; ++ks) kf[(kt + 1) & 1][ks] = *(const LAS bf16x8*)(rp + (kt + 1) * 16 * KP + ks * 64); }
        __builtin_amdgcn_sched_barrier(0);
#pragma unroll
        for (int qb = 0; qb < 2; ++qb) { f32x4 acc = (f32x4){0.f, 0.f, 0.f, 0.f};
#pragma unroll
            for (int ks = 0; ks < 4; ++ks) acc = A2_MFMA(kf[kt & 1][ks], qf[qb][ks], acc);
            s[qb][kt] = acc; }
        __builtin_amdgcn_sched_barrier(0);
    }
}
__device__ __forceinline__ void partial_sm(f32x4 (&s)[2][4], float (&m)[2], float (&al)[2]) {
    float pm[2];
#pragma unroll
    for (int qb = 0; qb < 2; ++qb) { float v = fmaxf(fmaxf(s[qb][0][0], s[qb][0][1]), fmaxf(s[qb][0][2], s[qb][0][3]));
#pragma unroll
        for (int kt = 1; kt < 4; ++kt) v = fmaxf(v, fmaxf(fmaxf(s[qb][kt][0], s[qb][kt][1]), fmaxf(s[qb][kt][2], s[qb][kt][3])));
        pm[qb] = xmax4(v); }
    float mn[2];
    if (__builtin_expect(__all((pm[0] - m[0] <= THR / SCALE) && (pm[1] - m[1] <= THR / SCALE)), 1)) { mn[0] = m[0]; mn[1] = m[1]; al[0] = 1.f; al[1] = 1.f; }
    else {
#pragma unroll
        for (int qb = 0; qb < 2; ++qb) { mn[qb] = fmaxf(m[qb], pm[qb]); al[qb] = __builtin_amdgcn_exp2f((m[qb] - mn[qb]) * CL2); m[qb] = mn[qb]; } }
#pragma unroll
    for (int qb = 0; qb < 2; ++qb) { const float mc = -mn[qb] * CL2;
#pragma unroll
        for (int kt = 0; kt < 4; ++kt)
#pragma unroll
            for (int i = 0; i < 4; ++i) s[qb][kt][i] = fmaf(s[qb][kt][i], CL2, mc);
#pragma unroll
        for (int kt = 0; kt < 2; ++kt)
#pragma unroll
            for (int i = 0; i < 4; ++i) s[qb][kt][i] = __builtin_amdgcn_exp2f(s[qb][kt][i]); }
}
__device__ __forceinline__ void finish_sm(f32x4 (&s)[2][4], const float (&al)[2], float (&l)[2], bf16x8 (&pf)[2][2]) {
#pragma unroll
    for (int qb = 0; qb < 2; ++qb) {
#pragma unroll
        for (int kt = 2; kt < 4; ++kt)
#pragma unroll
            for (int i = 0; i < 4; ++i) s[qb][kt][i] = __builtin_amdgcn_exp2f(s[qb][kt][i]);
        float ps = 0.f;
#pragma unroll
        for (int kt = 0; kt < 4; ++kt) ps += (s[qb][kt][0] + s[qb][kt][1]) + (s[qb][kt][2] + s[qb][kt][3]);
        l[qb] = l[qb] * al[qb] + ps;
#pragma unroll
        for (int u = 0; u < 2; ++u) { const v4u w = (v4u){cvtpk2(s[qb][2 * u][0], s[qb][2 * u][1]), cvtpk2(s[qb][2 * u][2], s[qb][2 * u][3]), cvtpk2(s[qb][2 * u + 1][0], s[qb][2 * u + 1][1]), cvtpk2(s[qb][2 * u + 1][2], s[qb][2 * u + 1][3])};
            pf[qb][u] = __builtin_bit_cast(bf16x8, w); } }
}
__device__ __forceinline__ void pv(f32x4 (&o)[2][8], const LAS unsigned char* vb, const bf16x8 (&pf)[2][2], int fr, int fq) {
    const LAS unsigned char* rp = vb + fr * TP + fq * 8;
    s16x4 lo[2][2], hi[2][2];
#pragma unroll
    for (int u = 0; u < 2; ++u) { lo[0][u] = *(const LAS s16x4*)(rp + u * 64); hi[0][u] = *(const LAS s16x4*)(rp + u * 64 + 32); }
#pragma unroll
    for (int dt = 0; dt < 8; ++dt) {
        if (dt + 1 < 8) {
#pragma unroll
            for (int u = 0; u < 2; ++u) { lo[(dt + 1) & 1][u] = *(const LAS s16x4*)(rp + (dt + 1) * 16 * TP + u * 64); hi[(dt + 1) & 1][u] = *(const LAS s16x4*)(rp + (dt + 1) * 16 * TP + u * 64 + 32); } }
        __builtin_amdgcn_sched_barrier(0);
#pragma unroll
        for (int u = 0; u < 2; ++u) { const bf16x8 vf = __builtin_shufflevector(lo[dt & 1][u], hi[dt & 1][u], 0, 1, 2, 3, 4, 5, 6, 7);
#pragma unroll
            for (int qb = 0; qb < 2; ++qb) o[qb][dt] = A2_MFMA(vf, pf[qb][u], o[qb][dt]); }
        __builtin_amdgcn_sched_barrier(0);
    }
}
__device__ __forceinline__ void resc(f32x4 (&o)[2][8], const float (&al)[2]) {
    if (__any(al[0] < 1.f || al[1] < 1.f)) {
#pragma unroll
        for (int qb = 0; qb < 2; ++qb)
#pragma unroll
            for (int dt = 0; dt < 8; ++dt) o[qb][dt] = o[qb][dt] * al[qb]; }
}
__device__ __forceinline__ void attn_body16(const bf16_t* __restrict__ Qb, const bf16_t* __restrict__ Kh, const bf16_t* __restrict__ Vh, bf16_t* __restrict__ Ob, int seq, LAS unsigned char* lds, int wave, int lane) {
    const int fr = lane & 15, fq = lane >> 4;
    bf16x8 qf[2][4];
#pragma unroll
    for (int qb = 0; qb < 2; ++qb)
#pragma unroll
        for (int ks = 0; ks < 4; ++ks) qf[qb][ks] = *(const bf16x8*)(Qb + (size_t)(wave * 32 + 16 * qb + fr) * LDQ + 32 * ks + 8 * fq);
    f32x4 o[2][8];
#pragma unroll
    for (int qb = 0; qb < 2; ++qb)
#pragma unroll
        for (int dt = 0; dt < 8; ++dt) o[qb][dt] = (f32x4){0.f, 0.f, 0.f, 0.f};
    float m[2] = {-1e30f, -1e30f}, l[2] = {0.f, 0.f}, al[2];
    f32x4 s[2][4]; bf16x8 pf[2][2];
    Stg S; const int NT = seq / 64;
#define A2_SBAR() __builtin_amdgcn_sched_barrier(0)
    const bool late = wave >= 4;
    int vP = 2 * VBUF, vC = 0, vN = VBUF;
    sload(S, Kh, Vh, 0, wave, lane); swrite(S, lds, 0, 0, wave, lane); __syncthreads();
    sload(S, Kh, Vh, 64, wave, lane);
    for (int j = 0; j < NT; ++j) {
        const LAS unsigned char* kb = lds + A2_K + (j & 1) * KBUF;
        if (late && j > 0) { A2_SBAR(); pv(o, lds + A2_V + vP, pf, fr, fq); }
        A2_SBAR(); qkt(s, kb, qf, fr, fq);
        partial_sm(s, m, al); finish_sm(s, al, l, pf); resc(o, al); A2_SBAR();
        if (j + 1 < NT) swrite(S, lds, (j + 1) & 1, vN, wave, lane);
        if (!late) { A2_SBAR(); pv(o, lds + A2_V + vC, pf, fr, fq); }
        __syncthreads();
        if (j + 2 < NT) sload(S, Kh, Vh, (j + 2) * 64, wave, lane);
        { const int t_ = vP; vP = vC; vC = vN; vN = t_; }
    }
    if (late) pv(o, lds + A2_V + vP, pf, fr, fq);
#undef A2_SBAR
#pragma unroll
    for (int qb = 0; qb < 2; ++qb) { const float inv = 1.0f / xsum4(l[qb]);
        bf16_t* op = Ob + (size_t)(wave * 32 + 16 * qb + fr) * LDO + 4 * fq;
#pragma unroll
        for (int dt = 0; dt < 8; ++dt) { const f32x4 v = o[qb][dt] * inv; v2u w; w.x = cvtpk2(v[0], v[1]); w.y = cvtpk2(v[2], v[3]); *(v2u*)(op + 16 * dt) = w; } }
}
}
__device__ __forceinline__ void phase_attn(Frame& F, char* lds_generic) {
    unsigned char* ws = F.ws;
    const bf16_t* Q1 = (const bf16_t*)(ws + WS_Q1); const bf16_t* K1 = (const bf16_t*)(ws + WS_K1); const bf16_t* V1 = (const bf16_t*)(ws + WS_V1); bf16_t* HA = (bf16_t*)(ws + WS_HA);
    const int xcd = F.bx & 7, loc = F.bx >> 3;
    for (int i = 0; ; ++i) {
        int u;
        if (F.G == 256) { const int hg = i * 8 + xcd; if (hg >= 32) break; u = (hg >> 1) * 64 + (hg & 1) * 32 + loc; }
        else { u = i * F.G + F.bx; if (u >= 1024) break; }
        const int g = u >> 6, w = u & 63, b = g >> 2, kvh = g & 3, hq = kvh * 4 + (w >> 4), qb = w & 15;
        const size_t qrow = (size_t)b * RB + qb * 256;
#if !defined(MK_ATTN16)
        att::attn_dense_body<att::bf16>(Q1 + qrow * LDA2 + hq * 128, K1 + (size_t)b * RB * LDKV + kvh * 128, V1 + (size_t)b * RB * LDKV + kvh * 128, HA + qrow * LDA2 + hq * 128, RB, lds_generic);
#else
        att2::attn_body16(Q1 + qrow * LDA2 + hq * 128, K1 + (size_t)b * RB * LDKV + kvh * 128, V1 + (size_t)b * RB * LDKV + kvh * 128, HA + qrow * LDA2 + hq * 128, RB, F.lds, F.wave, F.lane);
#endif
        __syncthreads();
    }
}
#ifndef MK_N_LAUNCHES
#define MK_N_LAUNCHES 1
#endif
constexpr int N_PHASES = 18;
#ifndef MK_DUP
#define MK_DUP 0u
#endif
#define REP(k) for (int rep_ = 0; rep_ < 1 + (int)(((MK_DUP) >> (k)) & 1u); ++rep_)
__global__ void __launch_bounds__(NTHREADS, 2) mega_fwd(Args a) {
    extern __shared__ __attribute__((aligned(16))) unsigned char lds[];
    Frame F;
    F.lds = (LAS unsigned char*)lds; F.MISC = (volatile LAS unsigned*)(F.lds + MISC_OFF);
    F.tid = threadIdx.x; F.lane = F.tid & 63; F.wave = __builtin_amdgcn_readfirstlane(F.tid >> 6);
    F.G = gridDim.x; F.bx = blockIdx.x; F.vcu = (F.G % 8 == 0) ? (F.bx % 8) * (F.G / 8) + F.bx / 8 : F.bx;
    F.ws = a.ws;
    unsigned char* ws = a.ws;
    if (F.tid < 128) F.MISC[F.tid] = 0u;
    __syncthreads();
    const int lo = a.ph_lo, hi = a.ph_hi;
    XcdBarrier bar; bar.bar = (unsigned*)(ws + WS_CTL) + CW_BAR + a.li * XCD_BAR_WORDS; bar.x = 0; bar.st = nullptr;
    if (hi - lo > 1) bar = xcd_barrier_post((unsigned*)(ws + WS_CTL) + CW_BAR + a.li * XCD_BAR_WORDS, F.MISC + 8);
#define IN(k) (lo <= (k) && (k) < hi)
#define SEAM(k) do { if (IN(k) && IN((k) + 1)) xcd_barrier(bar); } while (0)
    bf16_t* HA = (bf16_t*)(ws + WS_HA); bf16_t* Yb = (bf16_t*)(ws + WS_Y); bf16_t* PRJ = (bf16_t*)(ws + WS_PRJ); bf16_t* Hh = (bf16_t*)(ws + WS_PRJ);
    const bf16_t* WIN = (const bf16_t*)(ws + WS_WIN); const bf16_t* WMO = (const bf16_t*)(ws + WS_WMO); const bf16_t* WQKV = (const bf16_t*)(ws + WS_WQKV); const bf16_t* WAO = (const bf16_t*)(ws + WS_WAO);
    const bf16_t* WFI = (const bf16_t*)(ws + WS_WFI); const bf16_t* WFO = (const bf16_t*)(ws + WS_WFO);

    unsigned* const dctr = (unsigned*)(ws + WS_CTL) + 64;
    if (IN(0)) REP(0) { if (rep_) xcd_barrier(bar); phase_prep(F, a, dctr); } SEAM(0);
    if (IN(1)) REP(1) { if (rep_) xcd_barrier(bar); const RowCfg c{1, 0, 0, 1, 1, 0, 0, nullptr, 0, 0, 1, a.in[IN_GMIXPRE]}; phase_rows(F, a, c); } SEAM(1);
    constexpr int G2 = 238, G7 = 250;
    if (IN(2)) REP(2) { if (rep_) xcd_barrier(bar);
        const int gg = (F.G == 256) ? G2 : F.G;
        if (F.bx < gg) { pg8::Gemm g{HA, WIN, R, MIN_PAD, DM, LDA2, LDW}; pg8::Order S; S.init(68, 17, gg, F.bx, 0, 32); S.pn24 = 1; S.ctx_split(1, 16, 8);
            pg8::EpiInProj E{PRJ, (float*)(ws + WS_GATES), a.in[IN_BGATE]};
            pg8::gemm_phase<pg8::EpiInProj, pg8::Order, true, true>(F.lds, g, S, E); }
        mod_drain(F, a, dctr + 64, 64, 384); conv_items(F, a, dctr + 128, CV_A0, CV_B0, 2); } SEAM(2);
    if (IN(3)) REP(3) { if (rep_) xcd_barrier(bar);
#if defined(MK_SCAN_NAIVE)
        phase_scan_naive(F, a);
#else
#if defined(MK_SCANV)
        if (rep_ == 0) phase_scan_mfma<MK_SCANV>(F); else phase_scan_mfma<0>(F);
#else
        phase_scan_mfma<0>(F);
#endif
#endif
    } SEAM(3);
    bf16_t* HA2 = (bf16_t*)(ws + WS_PRJ);
    if (IN(4)) REP(4) { if (rep_) xcd_barrier(bar); phase_headnorm_ctx(F, a, HA2, PRJ_LD);
        pg8::Gemm g{HA, WIN + (size_t)4096 * LDW, R, DM, DM, LDA2, LDW}; pg8::Order S; S.init(64, 8, F.G, F.bx, 1, 32);
        pg8::EpiHeadNorm E{(const bf16_t*)(ws + WS_HF), (const bf16_t*)(ws + WS_HB), HA2, PRJ_LD, a.in[IN_GHEAD], (LAS float*)(F.lds + 131072)};
        pg8::gemm_phase<pg8::EpiHeadNorm, pg8::Order, true, true>(F.lds, g, S, E); } SEAM(4);
    if (IN(5)) REP(5) { if (rep_) xcd_barrier(bar); pg8::Gemm g{HA2, WMO, R, DM, DM, PRJ_LD, LDW}; pg8::Order S; S.init(64, 8, F.G, F.bx, 1, 32); S.ctx_split(4, 0, 8);
        pg8::EpiPlain E{Yb, LDA2, (bf16_t*)(ws + WS_YS)};
        pg8::gemm_phase<pg8::EpiPlain, pg8::Order, true, true>(F.lds, g, S, E); } SEAM(5);
    if (IN(6)) REP(6) { if (rep_) xcd_barrier(bar); const RowCfg c{1, 1, 1, 1, 1, 0, 2, a.in[IN_GMIXPOST], 0, 3, 4, a.in[IN_GFFNPRE]}; phase_rows(F, a, c); } SEAM(6);
    if (IN(7)) REP(7) { if (rep_) xcd_barrier(bar);
        const int gg = (F.G == 256) ? G7 : F.G;
        if (F.bx < gg) { pg8::Gemm g{HA, WFI, R, 2 * FF, DM, LDA2, LDW}; pg8::Order S; S.init(68, 44, gg, F.bx, 0, 32);
            pg8::EpiSwiglu E{Hh, LDF};
            pg8::gemm_phase<pg8::EpiSwiglu, pg8::Order, true, true>(F.lds, g, S, E); }
        conv_items(F, a, dctr + 192, CV_B0, CV_END, 2); } SEAM(7);
    if (IN(8)) REP(8) { if (rep_) xcd_barrier(bar); pg8::Gemm g{Hh, WFO, R, DM, FF, LDF, LDWF}; pg8::Order S; S.init(64, 8, F.G, F.bx, 1, 88); S.ctx_split(4, 0, 8);
        pg8::EpiPlain E{Yb, LDA2, (bf16_t*)(ws + WS_YS)};
        pg8::gemm_phase<pg8::EpiPlain, pg8::Order, true, true>(F.lds, g, S, E); } SEAM(8);
    if (IN(9)) REP(9) { if (rep_) xcd_barrier(bar); const RowCfg c{0, 1, 1, 1, 1, 0, 5, a.in[IN_GFFNPOST], 1, 0, 1, a.in[IN_GMIXPRE] + DM}; phase_rows(F, a, c); } SEAM(9);
    if (IN(10)) REP(10) { if (rep_) xcd_barrier(bar); pg8::Gemm g{HA, WQKV, R, QKV_COLS, DM, LDA2, LDW}; pg8::Order S; S.init(64, 12, F.G, F.bx, 1, 32); S.ctx_split(8, 8, 4);
        pg8::EpiQkv E{(bf16_t*)(ws + WS_Q1), (bf16_t*)(ws + WS_K1), (bf16_t*)(ws + WS_V1), (bf16_t*)(ws + WS_QS), a.in[IN_GQ], a.in[IN_GK], (const float*)(ws + WS_ROPE), (LAS float*)(F.lds + 131072)};
        pg8::gemm_phase<pg8::EpiQkv, pg8::Order, true, true>(F.lds, g, S, E); } SEAM(10);
    if (IN(11)) REP(11) { if (rep_) xcd_barrier(bar); phase_qknorm(F, a); } SEAM(11);
    if (IN(12)) REP(12) { if (rep_) xcd_barrier(bar); phase_attn(F, (char*)lds); } SEAM(12);
    if (IN(13)) REP(13) { if (rep_) xcd_barrier(bar); pg8::Gemm g{HA, WAO, R, DM, DM, LDA2, LDW}; pg8::Order S; S.init(64, 8, F.G, F.bx, 1, 32);
        pg8::EpiPlain E{Yb, LDA2, (bf16_t*)(ws + WS_YS)};
        pg8::gemm_phase<pg8::EpiPlain, pg8::Order, true, true>(F.lds, g, S, E); } SEAM(13);
    if (IN(14)) REP(14) { if (rep_) xcd_barrier(bar); const RowCfg c{0, 1, 1, 1, 0, 1, 2, a.in[IN_GMIXPOST] + DM, 1, 3, 4, a.in[IN_GFFNPRE] + DM}; phase_rows(F, a, c); } SEAM(14);
    if (IN(15)) REP(15) { if (rep_) xcd_barrier(bar); pg8::Gemm g{HA, WFI + (size_t)2 * FF * LDW, R, 2 * FF, DM, LDA2, LDW}; pg8::Order S; S.init(64, 44, F.G, F.bx, 1, 32);
        pg8::EpiSwiglu E{Hh, LDF};
        pg8::gemm_phase<pg8::EpiSwiglu, pg8::Order, true, true>(F.lds, g, S, E); } SEAM(15);
    if (IN(16)) REP(16) { if (rep_) xcd_barrier(bar); pg8::Gemm g{Hh, WFO + (size_t)DM * LDWF, R, DM, FF, LDF, LDWF}; pg8::Order S; S.init(64, 8, F.G, F.bx, 1, 88);
        pg8::EpiPlain E{Yb, LDA2, (bf16_t*)(ws + WS_YS)};
        pg8::gemm_phase<pg8::EpiPlain, pg8::Order, true, true>(F.lds, g, S, E); } SEAM(16);
    if (IN(17)) REP(17) { if (rep_) xcd_barrier(bar); const RowCfg c{0, 1, 2, 0, 0, 1, 5, a.in[IN_GFFNPOST] + DM, 0, 0, 0, nullptr}; phase_rows(F, a, c); }
#undef IN
#undef SEAM
}

extern "C" void kernel_launch(void* const* d_in, const int* in_sizes, int n_in, void* d_out, int out_size, void* d_ws, size_t ws_size, hipStream_t stream) {
    static int grid = 0;
    if (grid == 0) {
        if (n_in != 20 || out_size != BATCH * SEQ * DM || ws_size < WS_END) { fprintf(stderr, "kernel_launch: unexpected shapes: n_in %d out %d ws %zu (need %zu)\n", n_in, out_size, ws_size, (size_t)WS_END); grid = -1; return; }
        int dev = 0, cus = 0, per_cu = 0;
        if (hipGetDevice(&dev) != hipSuccess || hipDeviceGetAttribute(&cus, hipDeviceAttributeMultiprocessorCount, dev) != hipSuccess) { grid = -1; return; }
        if (hipFuncSetAttribute((const void*)mega_fwd, hipFuncAttributeMaxDynamicSharedMemorySize, LDS_BYTES) != hipSuccess) { fprintf(stderr, "kernel_launch: hipFuncSetAttribute failed\n"); grid = -1; return; }
        if (hipOccupancyMaxActiveBlocksPerMultiprocessor(&per_cu, (const void*)mega_fwd, NTHREADS, LDS_BYTES) != hipSuccess || per_cu < 1) { fprintf(stderr, "kernel_launch: occupancy query says %d\n", per_cu); }
        (void)hipGetLastError();
        grid = cus;
    }
    if (grid < 0) return;
    (void)hipMemsetAsync((char*)d_ws + WS_CTL, 0, CTL_ZERO_BYTES, stream);
    Args a{};
    for (int i = 0; i < 20; ++i) a.in[i] = (const float*)d_in[i];
    a.out = (float*)d_out; a.ws = (unsigned char*)d_ws; a.pad = 0;
#if MK_N_LAUNCHES == 1
    a.ph_lo = 0; a.ph_hi = N_PHASES; a.li = 0;
    hipLaunchKernelGGL(mega_fwd, dim3(grid), dim3(NTHREADS), LDS_BYTES, stream, a);
#else
    for (int p = 0; p < N_PHASES; ++p) { a.ph_lo = p; a.ph_hi = p + 1; a.li = 0;
        hipLaunchKernelGGL(mega_fwd, dim3(grid), dim3(NTHREADS), LDS_BYTES, stream, a); }
#endif
    const hipError_t le = hipPeekAtLastError();
    if (le != hipSuccess) fprintf(stderr, "kernel_launch: launch failed: %s\n", hipGetErrorName(le));
}
```

```cpp
#include <hip/hip_runtime.h>
#include <cstdio>
#include <cstdint>

constexpr int BATCH = 4, SEQ = 4096, CTXL = 256, DM = 2048;
constexpr int RB = SEQ + CTXL;
constexpr int R = BATCH * RB;
constexpr int NMOD = 6 * DM;
constexpr int MH = 8, MDK = 128, MDV = 256, MIN_COLS = 6176, MIN_PAD = 6400;
constexpr int FF = 5632;
constexpr int AHQ = 16, AHKV = 4, ADH = 128, QKV_COLS = 3072;
constexpr float NORM_EPS = 1e-6f;
constexpr int NWAVES = 8, NTHREADS = 512;

constexpr int LDA2 = DM + 64;
constexpr int LDF = FF + 64;
constexpr int LDW = DM + 64, LDWF = FF + 64;
constexpr int PRJ_LD = 6144 + 64;
constexpr int LDKV = 512 + 64;

constexpr size_t MiB = 1u << 20;
constexpr size_t WS_CTL = 0, CTL_ZERO_BYTES = 64 * 1024;
constexpr size_t WS_MOD = 1 * MiB;
constexpr size_t WS_WIN = 2 * MiB;
constexpr size_t WS_WMO = WS_WIN + (size_t)MIN_PAD * LDW * 2;
constexpr size_t WS_WQKV = WS_WMO + (size_t)DM * LDW * 2;
constexpr size_t WS_WAO = WS_WQKV + (size_t)QKV_COLS * LDW * 2;
constexpr size_t WS_WFI = WS_WAO + (size_t)DM * LDW * 2;
constexpr size_t WS_WFO = WS_WFI + (size_t)2 * 2 * FF * LDW * 2;
constexpr size_t WS_WEND = WS_WFO + (size_t)2 * DM * LDWF * 2;
constexpr size_t WS_X = 192 * MiB;
constexpr size_t WS_HA = 260 * MiB;
constexpr size_t WS_PRJ = 331 * MiB;
constexpr size_t WS_HF = 538 * MiB;
constexpr size_t WS_HB = 609 * MiB;
constexpr size_t WS_GATES = 680 * MiB;
constexpr size_t WS_YS = 683 * MiB;
constexpr size_t WS_QS = 700 * MiB;
constexpr size_t WS_ROPE = 716 * MiB;
constexpr size_t WS_END = 717 * MiB;
static_assert(WS_WEND <= WS_X, "weights fit");
static_assert(WS_X + (size_t)R * DM * 2 <= WS_HA && WS_HA + (size_t)R * LDA2 * 2 <= WS_PRJ && WS_PRJ + (size_t)R * PRJ_LD * 2 <= WS_HF && WS_HF + (size_t)R * LDA2 * 2 <= WS_HB && WS_HB + (size_t)R * LDA2 * 2 <= WS_GATES, "activation map");
static_assert(WS_GATES + (size_t)R * 32 * 4 <= WS_YS && WS_YS + (size_t)4 * 1024 * LDA2 * 2 <= WS_QS && WS_QS + (size_t)8 * 1024 * 1024 * 2 <= WS_END, "slab map");
constexpr size_t WS_Q1 = WS_PRJ, WS_K1 = WS_Q1 + (size_t)R * LDA2 * 2, WS_V1 = WS_K1 + (size_t)R * LDKV * 2;
static_assert(WS_V1 + (size_t)R * LDKV * 2 <= WS_HF && WS_PRJ + (size_t)R * LDF * 2 <= WS_HF, "qkv1 / H fit");
constexpr size_t WS_Y = WS_HF;
constexpr int CW_BAR = 4096;

constexpr int LDS_BYTES = 147456;
constexpr int MISC_OFF = LDS_BYTES - 512;

#define GAS __attribute__((address_space(1)))
#define LAS __attribute__((address_space(3)))
typedef unsigned short bf16_t;
typedef unsigned v4u __attribute__((ext_vector_type(4)));
typedef unsigned v2u __attribute__((ext_vector_type(2)));
typedef float f32x4 __attribute__((ext_vector_type(4)));
#define LDS_WAIT() asm volatile("s_waitcnt lgkmcnt(0)" ::: "memory")
#define VM_WAIT() asm volatile("s_waitcnt vmcnt(0)" ::: "memory")
__device__ __forceinline__ unsigned f2bf(float f) { unsigned u = __builtin_bit_cast(unsigned, f); return (u + 0x7fffu + ((u >> 16) & 1u)) >> 16; }
__device__ __forceinline__ unsigned pk2(float lo, float hi) { return f2bf(lo) | (f2bf(hi) << 16); }
__device__ __forceinline__ float bf2f(unsigned short b) { return __builtin_bit_cast(float, (unsigned)b << 16); }
__device__ __forceinline__ float bflo(unsigned w) { return __builtin_bit_cast(float, w << 16); }
__device__ __forceinline__ float bfhi(unsigned w) { return __builtin_bit_cast(float, w & 0xffff0000u); }
template <int CTRL> __device__ __forceinline__ float dpp_f(float v) { return __builtin_bit_cast(float, __builtin_amdgcn_update_dpp(0, __builtin_bit_cast(int, v), CTRL, 0xf, 0xf, false)); }
__device__ __forceinline__ float row_sum16(float v) { v += dpp_f<0xB1>(v); v += dpp_f<0x4E>(v); v += dpp_f<0x141>(v); v += dpp_f<0x140>(v); return v; }
__device__ __forceinline__ float rl_f(float v, int l) { return __builtin_bit_cast(float, __builtin_amdgcn_readlane(__builtin_bit_cast(int, v), l)); }
__device__ __forceinline__ float wave_sum(float v) { v = row_sum16(v); return (rl_f(v, 0) + rl_f(v, 16)) + (rl_f(v, 32) + rl_f(v, 48)); }
__device__ __forceinline__ float rcp_f(float v) { return __builtin_amdgcn_rcpf(v); }
__device__ __forceinline__ float rsq_f(float v) { return __builtin_amdgcn_rsqf(v); }
__device__ __forceinline__ float silu_f(float v) { return v / (1.0f + __expf(-v)); }
__device__ __forceinline__ float sigmoid_f(float v) { return 1.0f / (1.0f + __expf(-v)); }
typedef float sf32x2_t __attribute__((ext_vector_type(2))); typedef __bf16 sbf16x2_t __attribute__((ext_vector_type(2)));
__device__ __forceinline__ unsigned cvtpk2(float lo, float hi) { sf32x2_t v = {lo, hi}; sbf16x2_t b = __builtin_convertvector(v, sbf16x2_t); return __builtin_bit_cast(unsigned, b); }
namespace pg8 {
#define PG8_LAS __attribute__((address_space(3)))
typedef unsigned short bf16_t;
typedef short bf16x8 __attribute__((ext_vector_type(8)));
typedef float f32x4 __attribute__((ext_vector_type(4)));
typedef unsigned u32x4 __attribute__((ext_vector_type(4)));
constexpr int BM = 256, BK = 64, HALF = 128, HTB = HALF * BK * 2  , STAGE_BYTES = 8 * HTB, NXCD = 8, WGM = 8;

__host__ __device__ __forceinline__ int lds_byte(int r, int c) { const int st = (r >> 4) * 2 + (c >> 5), rr = r & 15, cc = c & 31, ob = rr * 64 + cc * 2; return st * 1024 + (ob ^ (((ob >> 9) & 1) << 5)); }
__host__ __device__ __forceinline__ void stage_rc(int b, int& R, int& C) { const int st = b / 1024, sb = b % 1024, swz = sb ^ (((sb >> 9) & 1) << 5); R = (st >> 1) * 16 + swz / 64; C = (st & 1) * 32 + (swz % 64) / 2; }
__host__ __device__ __forceinline__ int perm32(int rho) { const int n = rho >> 4, i = rho & 15; return 8 * (i >> 2) + 4 * n + (i & 3); }

struct Unit { int pm, pn, kt0, nt, slab; };
struct Gemm { const bf16_t* A; const bf16_t* Bt; int M, N, K, lda, ldb; };

__device__ __forceinline__ unsigned cvt_pk_bf16(float lo, float hi) { unsigned r; asm volatile("s_nop 1\n\tv_cvt_pk_bf16_f32 %0, %1, %2" : "=v"(r) : "v"(lo), "v"(hi)); return r; }
typedef float f32x2 __attribute__((ext_vector_type(2)));
struct Order {
    int nM, nN, nwg, G, c, latonly, ntk;
    int same = 0, allsplit = 0;
    int nsub, cpn0, cnN;
    int pn24 = 0;
    __device__ void init(int nM_, int nN_, int G_, int c_, int latonly_, int ntk_) { nM = nM_; nN = nN_; nwg = nM * nN; G = G_; c = c_; latonly = latonly_; ntk = ntk_; nsub = 0; cpn0 = 0; cnN = 0; }
    __device__ void ctx_split(int nsub_, int cpn0_, int cnN_) { nsub = nsub_; cpn0 = cpn0_; cnN = cnN_; }
    __device__ __forceinline__ bool next(int i, Unit& u) const {
        long L = (long)i * G + c; int aks = 0;
        if (allsplit) { if (L >= (long)nwg * allsplit) return false; aks = (int)(L % allsplit); L /= allsplit; }
        const bool sub = L >= nwg;
        const int nctx = nsub ? 4 * cnN * nsub : 0;
        const int e = sub ? (int)(L - nwg) : 0;
        const bool ok = sub ? (e < nctx) : true;
        const int ns = nsub ? nsub : 1, cn = cnN ? cnN : 1;
        const int ks = e % ns, r = e / ns;
        int wgid = sub ? 0 : (int)L; { const int q = nwg / NXCD, rr = nwg % NXCD, xcd = wgid % NXCD, off = wgid / NXCD; wgid = (xcd < rr ? xcd * (q + 1) : rr * (q + 1) + (xcd - rr) * q) + off; }
        const int nig = WGM * nN, gid = wgid / nig, fm = gid * WGM, gsz = (nM - fm) < WGM ? (nM - fm) : WGM;
        const int pm0 = fm + ((wgid % nig) % gsz), pn0 = (wgid % nig) / gsz;
        const int pm1 = latonly ? pm0 + (pm0 >> 4) : pm0;
        const int snt = ntk / ns;
        u.pm = same ? 0 : (sub ? 17 * (r / cn) + 16 : pm1);
        u.pn = same ? 0 : (sub ? cpn0 + r % cn : ((pn24 && pn0 == 16) ? 24 : pn0));
        u.nt = sub ? snt : (allsplit ? ntk / allsplit : ntk);
        u.kt0 = sub ? ks * snt : (allsplit ? aks * (ntk / allsplit) : 0);
        u.slab = sub ? ks : -1;
        return ok;
    }
    __device__ __forceinline__ void a_ready(const Unit&) const {}
    __device__ __forceinline__ void done(const Unit&) const {}
};

__device__ __forceinline__ u32x4 pack8(const f32x4 v0, const f32x4 v1) { u32x4 w; w.x = cvt_pk_bf16(v0[0], v0[1]); w.y = cvt_pk_bf16(v0[2], v0[3]); w.z = cvt_pk_bf16(v1[0], v1[1]); w.w = cvt_pk_bf16(v1[2], v1[3]); return w; }

struct EpiPlain {
    static constexpr bool PERM = true, AFTER_DRAIN = false;
    bf16_t* O; int ldc; bf16_t* OS;
    __device__ __forceinline__ void operator()(const f32x4 (&acc)[2][2][4][2], const Unit& u, int wr, int wc, int fr, int fq) const {
        const int col0 = u.pn * BM + wc * 32 + 8 * fq; int row0 = u.pm * BM + wr * 64 + fr; bf16_t* base = O;
        if (u.slab >= 0) { row0 = (u.slab * 4 + u.pm / 17) * BM + wr * 64 + fr; base = OS; }
#pragma unroll
        for (int ai = 0; ai < 2; ++ai)
#pragma unroll
            for (int m = 0; m < 4; ++m) { bf16_t* rowp = base + (size_t)(row0 + ai * HALF + m * 16) * ldc + col0;
#pragma unroll
                for (int bj = 0; bj < 2; ++bj) *(u32x4*)(rowp + bj * HALF) = pack8(acc[ai][bj][m][0], acc[ai][bj][m][1]); }
    }
};
struct EpiQkv {
    static constexpr bool PERM = true, AFTER_DRAIN = false;
    bf16_t* Q; bf16_t* K; bf16_t* V; bf16_t* QS;
    const float* gq; const float* gk; const float* rope;
    PG8_LAS float* xt;
    __device__ __forceinline__ void operator()(const f32x4 (&acc)[2][2][4][2], const Unit& u, int wr, int wc, int fr, int fq) const {
        int row0 = u.pm * BM + wr * 64 + fr; bf16_t* base; int ldc, colt;
        if (u.slab >= 0) { base = QS; ldc = 1024; colt = (u.pn - 8) * BM; row0 = (u.slab * 4 + u.pm / 17) * BM + wr * 64 + fr; }
        else if (u.pn < 8) { base = Q; ldc = 2112; colt = u.pn * BM; } else if (u.pn < 10) { base = K; ldc = 576; colt = (u.pn - 8) * BM; } else { base = V; ldc = 576; colt = (u.pn - 10) * BM; }
        const int col0 = colt + wc * 32 + 8 * fq;
        if (u.slab >= 0 || u.pn >= 10) {
#pragma unroll
            for (int ai = 0; ai < 2; ++ai)
#pragma unroll
                for (int m = 0; m < 4; ++m) { bf16_t* rowp = base + (size_t)(row0 + ai * HALF + m * 16) * ldc + col0;
#pragma unroll
                    for (int bj = 0; bj < 2; ++bj) *(u32x4*)(rowp + bj * HALF) = pack8(acc[ai][bj][m][0], acc[ai][bj][m][1]); }
            return;
        }
        const int lr0 = wr * 64 + fr;
        const float* g = (u.pn < 8) ? gq : gk; const int hc0 = wc * 32 + 8 * fq;
        const f32x4 g0 = *(const f32x4*)(g + hc0), g1 = *(const f32x4*)(g + hc0 + 4);
        const int f0 = (16 * wc + 4 * fq) & 31;
        f32x4 tab[4][2];
#pragma unroll
        for (int j = 0; j < 4; ++j) { const int pos = (wc < 2) ? (4 * (u.pm % 17) + wr + 2 * (j & 1)) : (fr + 16 * j);
            tab[j][0] = *(const f32x4*)(rope + (pos * 32 + f0) * 2); tab[j][1] = *(const f32x4*)(rope + (pos * 32 + f0 + 2) * 2); }
#pragma unroll
        for (int ai = 0; ai < 2; ++ai)
#pragma unroll
            for (int m = 0; m < 4; ++m)
#pragma unroll
                for (int bj = 0; bj < 2; ++bj) { const f32x4 a0 = acc[ai][bj][m][0], a1 = acc[ai][bj][m][1];
                    float s = ((a0[0] * a0[0] + a0[1] * a0[1]) + (a0[2] * a0[2] + a0[3] * a0[3])) + ((a1[0] * a1[0] + a1[1] * a1[1]) + (a1[2] * a1[2] + a1[3] * a1[3]));
                    s += __shfl_xor(s, 16); s += __shfl_xor(s, 32);
                    if (fq == 0) xt[((lr0 + ai * HALF + m * 16) * 2 + bj) * 4 + wc] = s; }
        asm volatile("s_waitcnt lgkmcnt(0)" ::: "memory"); __builtin_amdgcn_s_barrier(); asm volatile("" ::: "memory");
#pragma unroll
        for (int ai = 0; ai < 2; ++ai)
#pragma unroll
            for (int m = 0; m < 4; ++m) {
                const f32x4 c0 = (wc < 2) ? tab[ai][0] : tab[m][0], c1 = (wc < 2) ? tab[ai][1] : tab[m][1];
                bf16_t* rowp = base + (size_t)(row0 + ai * HALF + m * 16) * ldc + col0;
#pragma unroll
                for (int bj = 0; bj < 2; ++bj) { const f32x4 tv = *(const PG8_LAS f32x4*)(xt + ((lr0 + ai * HALF + m * 16) * 2 + bj) * 4);
                    const float rstd = rsq_f(((tv[0] + tv[1]) + (tv[2] + tv[3])) * (1.0f / 128.0f) + 1e-6f);
                    const f32x4 x0 = acc[ai][bj][m][0] * rstd * g0, x1 = acc[ai][bj][m][1] * rstd * g1;
                    const f32x4 y0 = (f32x4){x0[0] * c0[0] - x0[1] * c0[1], x0[0] * c0[1] + x0[1] * c0[0], x0[2] * c0[2] - x0[3] * c0[3], x0[2] * c0[3] + x0[3] * c0[2]};
                    const f32x4 y1 = (f32x4){x1[0] * c1[0] - x1[1] * c1[1], x1[0] * c1[1] + x1[1] * c1[0], x1[2] * c1[2] - x1[3] * c1[3], x1[2] * c1[3] + x1[3] * c1[2]};
                    *(u32x4*)(rowp + bj * HALF) = pack8(y0, y1); } }
    }
};
struct EpiSwiglu {
    static constexpr bool PERM = true, AFTER_DRAIN = false;
    bf16_t* H; int ldc;
    __device__ __forceinline__ void operator()(const f32x4 (&acc)[2][2][4][2], const Unit& u, int wr, int wc, int fr, int fq) const {
        const int row0 = u.pm * BM + wr * 64 + fr, col0 = u.pn * HALF + wc * 32 + 8 * fq;
#pragma unroll
        for (int ai = 0; ai < 2; ++ai)
#pragma unroll
            for (int m = 0; m < 4; ++m) { bf16_t* rowp = H + (size_t)(row0 + ai * HALF + m * 16) * ldc + col0;
                f32x4 r0, r1;
#pragma unroll
                for (int j = 0; j < 4; ++j) { const float g0 = acc[ai][0][m][0][j], g1 = acc[ai][0][m][1][j];
                    r0[j] = g0 * rcp_f(1.0f + __expf(-g0)) * acc[ai][1][m][0][j]; r1[j] = g1 * rcp_f(1.0f + __expf(-g1)) * acc[ai][1][m][1][j]; }
                *(u32x4*)rowp = pack8(r0, r1); }
    }
};
struct EpiInProj {
    static constexpr bool PERM = true, AFTER_DRAIN = false;
    bf16_t* PRJ; float* GATES; const float* bgate;
    __device__ __forceinline__ void operator()(const f32x4 (&acc)[2][2][4][2], const Unit& u, int wr, int wc, int fr, int fq) const {
        const int row0 = u.pm * BM + wr * 64 + fr;
        if (u.pn < 24) {
            const float sc = (u.pn < 4) ? 0.08838834764831845f : 1.0f; const bool sig = (u.pn >= 16);
            const int col0 = u.pn * BM + wc * 32 + 8 * fq;
#pragma unroll
            for (int ai = 0; ai < 2; ++ai)
#pragma unroll
                for (int m = 0; m < 4; ++m) { bf16_t* rowp = PRJ + (size_t)(row0 + ai * HALF + m * 16) * 6208 + col0;
#pragma unroll
                    for (int bj = 0; bj < 2; ++bj) { f32x4 v0 = acc[ai][bj][m][0] * sc, v1 = acc[ai][bj][m][1] * sc;
                        if (sig) {
#pragma unroll
                            for (int j = 0; j < 4; ++j) { v0[j] = rcp_f(1.0f + __expf(-v0[j])); v1[j] = rcp_f(1.0f + __expf(-v1[j])); } }
                        *(u32x4*)(rowp + bj * HALF) = pack8(v0, v1); } }
        } else if (wc == 0) {
#pragma unroll
            for (int ai = 0; ai < 2; ++ai)
#pragma unroll
                for (int m = 0; m < 4; ++m) { float* rowp = GATES + (size_t)(row0 + ai * HALF + m * 16) * 32 + 8 * fq;
#pragma unroll
                    for (int n = 0; n < 2; ++n) { f32x4 g;
#pragma unroll
                        for (int j = 0; j < 4; ++j) { float v = acc[ai][0][m][n][j] + bgate[8 * fq + 4 * n + j];
                            v = 15.0f - 30.0f * rcp_f(__expf(v * (2.0f / 15.0f)) + 1.0f);
                            if (fq & 1) v = fminf(v, 0.0f) - __logf(1.0f + __expf(-fabsf(v)));
                            g[j] = v; }
                        *(f32x4*)(rowp + 4 * n) = g; } }
        }
    }
};

struct EpiHeadNorm {
    static constexpr bool PERM = true, AFTER_DRAIN = false;
    const bf16_t* HF; const bf16_t* HB; bf16_t* O; int ldo; const float* gh;
    PG8_LAS float* xt;
    __device__ __forceinline__ void operator()(const f32x4 (&acc)[2][2][4][2], const Unit& u, int wr, int wc, int fr, int fq) const {
        const int lr0 = wr * 64 + fr, colh = u.pn * BM + wc * 32 + 8 * fq;
        const unsigned lofs = (unsigned)(((wr * 64 + fr) * 2112 + wc * 32 + 8 * fq) * 2);
        const char* hfu = (const char*)HF + ((size_t)u.pm * BM * 2112 + (size_t)u.pn * BM) * 2; const char* hbu = (const char*)HB + ((size_t)u.pm * BM * 2112 + (size_t)u.pn * BM) * 2;
        u32x4 sga[2][2][4];
#pragma unroll
        for (int ai = 0; ai < 2; ++ai)
#pragma unroll
            for (int bj = 0; bj < 2; ++bj)
#pragma unroll
                for (int m = 0; m < 4; ++m) { f32x4 v0, v1;
#pragma unroll
                    for (int j = 0; j < 4; ++j) { v0[j] = rcp_f(1.0f + __expf(-acc[ai][bj][m][0][j])); v1[j] = rcp_f(1.0f + __expf(-acc[ai][bj][m][1][j])); }
                    sga[ai][bj][m] = pack8(v0, v1); }
        __builtin_amdgcn_sched_barrier(0); asm volatile("" ::: "memory");
#pragma unroll
        for (int ai = 0; ai < 2; ++ai) {
            u32x4 hf[2][4], hb[2][4];
#pragma unroll
            for (int m = 0; m < 4; ++m)
#pragma unroll
                for (int bj = 0; bj < 2; ++bj) { const size_t uo = ((size_t)(ai * HALF + m * 16) * 2112 + bj * HALF) * 2;
                    hf[bj][m] = *(const u32x4*)(hfu + uo + lofs); hb[bj][m] = *(const u32x4*)(hbu + uo + lofs); }
            const u32x4 (&sg)[2][4] = sga[ai];
#pragma unroll
            for (int m = 0; m < 4; ++m)
#pragma unroll
                for (int bj = 0; bj < 2; ++bj) { const u32x4 f = hf[bj][m], b = hb[bj][m];
                    float s = 0.f;
#pragma unroll
                    for (int e = 0; e < 4; ++e) { const float h0 = bflo(f[e]) + bflo(b[e]), h1 = bfhi(f[e]) + bfhi(b[e]); s += h0 * h0 + h1 * h1; }
                    s += __shfl_xor(s, 16); s += __shfl_xor(s, 32);
                    if (fq == 0) xt[(lr0 + ai * HALF + m * 16) * 8 + bj * 4 + wc] = s; }
            asm volatile("s_waitcnt lgkmcnt(0)" ::: "memory"); __builtin_amdgcn_s_barrier(); asm volatile("" ::: "memory");
            f32x4 g[2][2];
#pragma unroll
            for (int bj = 0; bj < 2; ++bj) { g[bj][0] = *(const f32x4*)(gh + colh + bj * HALF); g[bj][1] = *(const f32x4*)(gh + colh + bj * HALF + 4); }
#pragma unroll
            for (int m = 0; m < 4; ++m) { const int lr = lr0 + ai * HALF + m * 16;
                const f32x4 t0 = *(const PG8_LAS f32x4*)(xt + lr * 8), t1 = *(const PG8_LAS f32x4*)(xt + lr * 8 + 4);
                const float rstd = rsq_f((((t0[0] + t0[1]) + (t0[2] + t0[3])) + ((t1[0] + t1[1]) + (t1[2] + t1[3]))) * (1.0f / 256.0f) + 1e-6f);
                bf16_t* rowp = O + (size_t)(u.pm * BM + lr) * ldo + colh;
#pragma unroll
                for (int bj = 0; bj < 2; ++bj) { const u32x4 f = hf[bj][m], b = hb[bj][m], sgv = sg[bj][m];
                    f32x4 v0, v1;
#pragma unroll
                    for (int e = 0; e < 2; ++e) {
                        v0[2 * e] = (bflo(f[e]) + bflo(b[e])) * rstd * g[bj][0][2 * e] * bflo(sgv[e]);
                        v0[2 * e + 1] = (bfhi(f[e]) + bfhi(b[e])) * rstd * g[bj][0][2 * e + 1] * bfhi(sgv[e]);
                        v1[2 * e] = (bflo(f[e + 2]) + bflo(b[e + 2])) * rstd * g[bj][1][2 * e] * bflo(sgv[e + 2]);
                        v1[2 * e + 1] = (bfhi(f[e + 2]) + bfhi(b[e + 2])) * rstd * g[bj][1][2 * e + 1] * bfhi(sgv[e + 2]); }
                    *(u32x4*)(rowp + bj * HALF) = pack8(v0, v1); } }
        }
    }
};

template <class Epi, class Sched, bool ALIGN_EPI = false, bool SP2 = false>
__device__ __forceinline__ void gemm_phase(PG8_LAS unsigned char* lds, const Gemm g, const Sched& S, const Epi& E) {
    const int tid = threadIdx.x, wid = __builtin_amdgcn_readfirstlane(tid >> 6), lane = tid & 63, wr = wid >> 2, wc = wid & 3, fr = lane & 15, fq = lane >> 4;
    unsigned voffA[2], voffB[2];
#pragma unroll
    for (int i = 0; i < 2; ++i) { int R, C; stage_rc(tid * 16 + i * 8192, R, C); const int Rb = Epi::PERM ? ((R & ~31) + perm32(R & 31)) : R;
        voffA[i] = (unsigned)(R * g.lda + C) * 2u; voffB[i] = (unsigned)(Rb * g.ldb + C) * 2u; }
    const size_t kstep = (size_t)(BK * 2);
    const size_t hstepA = (size_t)HALF * g.lda * 2, hstepB = (size_t)HALF * g.ldb * 2;
    const size_t tstepA = 2 * hstepA, tstepB = 2 * hstepB;
    const unsigned ldsw = (unsigned)wid * 1024u;
    const int aoff = lds_byte(wr * 64 + fr, fq * 8), boff = lds_byte(wc * 32 + fr, fq * 8);
#define PG8_SA(b, h) (((b) * 2 + (h)) * HTB)
#define PG8_SB(b, h) ((4 + (b) * 2 + (h)) * HTB)
#define PG8_STAGE(bufoff, gbase, voff) do { _Pragma("unroll") for (int _i = 0; _i < 2; ++_i) \
        __builtin_amdgcn_global_load_lds((const unsigned*)((const char*)(gbase) + (voff)[_i]), (PG8_LAS unsigned*)(lds + (bufoff) + ldsw + _i * 8192), 16, 0, 0); } while (0)
#define PG8_LDA(dst, b, h) do { _Pragma("unroll") for (int m = 0; m < 4; ++m) _Pragma("unroll") for (int k = 0; k < 2; ++k) dst[m][k] = *(const PG8_LAS bf16x8*)(lds + PG8_SA(b, h) + aoff + m * 2048 + k * 1024); } while (0)
#define PG8_LDB(dst, b, h) do { _Pragma("unroll") for (int n = 0; n < 2; ++n) _Pragma("unroll") for (int k = 0; k < 2; ++k) dst[n][k] = *(const PG8_LAS bf16x8*)(lds + PG8_SB(b, h) + boff + n * 2048 + k * 1024); } while (0)
#define PG8_MMA(ai, bj, At, Bt) do { __builtin_amdgcn_s_setprio(1); _Pragma("unroll") for (int m = 0; m < 4; ++m) _Pragma("unroll") for (int n = 0; n < 2; ++n) _Pragma("unroll") for (int k = 0; k < 2; ++k) \
        acc[ai][bj][m][n] = __builtin_amdgcn_mfma_f32_16x16x32_bf16(Bt[n][k], At[m][k], acc[ai][bj][m][n], 0, 0, 0); __builtin_amdgcn_s_setprio(0); } while (0)
#define PG8_WAIT_V(n) asm volatile("s_waitcnt vmcnt(" #n ")" ::: "memory")
#define PG8_WAIT_L(n) asm volatile("s_waitcnt lgkmcnt(" #n ")" ::: "memory")
#define PG8_BAR __builtin_amdgcn_s_barrier()
#define PG8_SCHED __builtin_amdgcn_sched_barrier(0)
    Unit cur, nxt; int ui = 0;
    if (!S.next(0, cur)) return;
    f32x4 acc[2][2][4][2];
#pragma unroll
    for (int a = 0; a < 2; ++a)
#pragma unroll
        for (int b = 0; b < 2; ++b)
#pragma unroll
            for (int m = 0; m < 4; ++m)
#pragma unroll
                for (int n = 0; n < 2; ++n) acc[a][b][m][n] = (f32x4){0.f, 0.f, 0.f, 0.f};
    bf16x8 At[4][2], B0[2][2], B1[2][2];
    const char* cA = (const char*)g.A + (size_t)cur.pm * tstepA + (size_t)cur.kt0 * kstep; const char* cB = (const char*)g.Bt + (size_t)cur.pn * tstepB + (size_t)cur.kt0 * kstep;
    S.a_ready(cur);
    if constexpr (SP2) {
        PG8_STAGE(PG8_SB(0, 0), cB, voffB); PG8_STAGE(PG8_SB(0, 1), cB + hstepB, voffB); PG8_STAGE(PG8_SA(0, 0), cA, voffA); PG8_STAGE(PG8_SA(0, 1), cA + hstepA, voffA);
        if (wr == 1) PG8_BAR;
        PG8_WAIT_V(2); PG8_BAR;
        PG8_STAGE(PG8_SB(1, 0), cB + kstep, voffB); PG8_STAGE(PG8_SA(1, 0), cA + kstep, voffA); PG8_STAGE(PG8_SB(1, 1), cB + hstepB + kstep, voffB);
        PG8_WAIT_V(6); PG8_BAR;
    } else {
        PG8_STAGE(PG8_SB(0, 0), cB, voffB); PG8_STAGE(PG8_SA(0, 0), cA, voffA); PG8_STAGE(PG8_SB(0, 1), cB + hstepB, voffB); PG8_STAGE(PG8_SA(0, 1), cA + hstepA, voffA);
        if (wr == 1) PG8_BAR;
        PG8_WAIT_V(4); PG8_BAR;
        PG8_STAGE(PG8_SB(1, 0), cB + kstep, voffB); PG8_STAGE(PG8_SA(1, 0), cA + kstep, voffA); PG8_STAGE(PG8_SB(1, 1), cB + hstepB + kstep, voffB);
        PG8_WAIT_V(6); PG8_BAR;
    }
    for (;;) {
        const bool has_next = S.next(ui + 1, nxt);
        const char* nA = has_next ? (const char*)g.A + (size_t)nxt.pm * tstepA + (size_t)nxt.kt0 * kstep : cA; const char* nB = has_next ? (const char*)g.Bt + (size_t)nxt.pn * tstepB + (size_t)nxt.kt0 * kstep : cB;
        const int cnt = cur.nt;
        for (int t = 0; t < cnt; t += 2) {
            const bool last = (t == cnt - 2);
            const char* a1 = cA + (size_t)(t + 1) * kstep;
            const char* a2 = last ? nA : cA + (size_t)(t + 2) * kstep; const char* b2 = last ? nB : cB + (size_t)(t + 2) * kstep;
            const char* a3 = a2 + kstep; const char* b3 = b2 + kstep;
            if (last && has_next) S.a_ready(nxt);
            if constexpr (SP2) {
            PG8_LDB(B0, 0, 0); PG8_LDB(B1, 0, 1); PG8_SCHED; PG8_LDA(At, 0, 0); PG8_STAGE(PG8_SA(1, 1), a1 + hstepA, voffA);
            PG8_WAIT_V(8); PG8_WAIT_L(0); PG8_BAR; PG8_MMA(0, 0, At, B0); PG8_MMA(0, 1, At, B1); PG8_BAR; PG8_SCHED;
            PG8_LDA(At, 0, 1); PG8_STAGE(PG8_SB(0, 0), b2, voffB); PG8_STAGE(PG8_SB(0, 1), b2 + hstepB, voffB); PG8_STAGE(PG8_SA(0, 0), a2, voffA);
            PG8_WAIT_V(8); PG8_WAIT_L(0); PG8_BAR; PG8_MMA(1, 0, At, B0); PG8_MMA(1, 1, At, B1); PG8_BAR; PG8_SCHED;
            PG8_LDB(B0, 1, 0); PG8_LDB(B1, 1, 1); PG8_SCHED; PG8_LDA(At, 1, 0); PG8_STAGE(PG8_SA(0, 1), a2 + hstepA, voffA);
            PG8_WAIT_V(8); PG8_WAIT_L(0); PG8_BAR; PG8_MMA(0, 0, At, B0); PG8_MMA(0, 1, At, B1); PG8_BAR; PG8_SCHED;
            PG8_LDA(At, 1, 1); PG8_STAGE(PG8_SB(1, 0), b3, voffB); PG8_STAGE(PG8_SB(1, 1), b3 + hstepB, voffB); PG8_STAGE(PG8_SA(1, 0), a3, voffA);
            PG8_WAIT_V(8); PG8_WAIT_L(0); PG8_BAR; PG8_MMA(1, 0, At, B0); PG8_MMA(1, 1, At, B1); PG8_BAR; PG8_SCHED;
            } else {
            PG8_LDB(B0, 0, 0); PG8_SCHED; PG8_LDA(At, 0, 0); PG8_STAGE(PG8_SA(1, 1), a1 + hstepA, voffA);
            PG8_WAIT_L(8); PG8_BAR; PG8_WAIT_L(0); PG8_MMA(0, 0, At, B0); PG8_BAR; PG8_SCHED;
            PG8_LDB(B1, 0, 1); PG8_STAGE(PG8_SB(0, 0), b2, voffB);
            PG8_BAR; PG8_WAIT_L(0); PG8_MMA(0, 1, At, B1); PG8_BAR;
            PG8_LDA(At, 0, 1); PG8_STAGE(PG8_SA(0, 0), a2, voffA);
            PG8_BAR; PG8_WAIT_L(0); PG8_MMA(1, 0, At, B0); PG8_BAR; PG8_SCHED;
            PG8_STAGE(PG8_SB(0, 1), b2 + hstepB, voffB);
            PG8_WAIT_V(6); PG8_BAR; PG8_MMA(1, 1, At, B1); PG8_BAR;
            PG8_LDB(B0, 1, 0); PG8_SCHED; PG8_LDA(At, 1, 0); PG8_STAGE(PG8_SA(0, 1), a2 + hstepA, voffA);
            PG8_WAIT_L(8); PG8_BAR; PG8_WAIT_L(0); PG8_MMA(0, 0, At, B0); PG8_BAR; PG8_SCHED;
            PG8_LDB(B1, 1, 1); PG8_STAGE(PG8_SB(1, 0), b3, voffB);
            PG8_BAR; PG8_WAIT_L(0); PG8_MMA(0, 1, At, B1); PG8_BAR;
            PG8_LDA(At, 1, 1); PG8_STAGE(PG8_SA(1, 0), a3, voffA);
            PG8_BAR; PG8_WAIT_L(0); PG8_MMA(1, 0, At, B0); PG8_BAR; PG8_SCHED;
            PG8_STAGE(PG8_SB(1, 1), b3 + hstepB, voffB);
            PG8_WAIT_V(6); PG8_BAR; PG8_MMA(1, 1, At, B1); PG8_BAR;
            }
        }
        if constexpr (ALIGN_EPI) { if (wr == 0) PG8_BAR; }
        if constexpr (!Epi::AFTER_DRAIN) { E(acc, cur, wr, wc, fr, fq); S.done(cur); }
        if (!has_next) break;
#pragma unroll
        for (int a = 0; a < 2; ++a)
#pragma unroll
            for (int b = 0; b < 2; ++b)
#pragma unroll
                for (int m = 0; m < 4; ++m)
#pragma unroll
                    for (int n = 0; n < 2; ++n) acc[a][b][m][n] = (f32x4){0.f, 0.f, 0.f, 0.f};
        cur = nxt; cA = nA; cB = nB; ++ui;
        if constexpr (ALIGN_EPI) { if (wr == 1) PG8_BAR; }
    }
    PG8_WAIT_V(0);
    if constexpr (!ALIGN_EPI) { if (wr == 0) PG8_BAR; }
    PG8_BAR;
    if constexpr (Epi::AFTER_DRAIN) { E.fused(acc, cur, wr, wc, fr, fq, lds, wid, lane); S.done(cur); }
#undef PG8_SA
#undef PG8_SB
#undef PG8_STAGE
#undef PG8_LDA
#undef PG8_LDB
#undef PG8_MMA
#undef PG8_WAIT_V
#undef PG8_WAIT_L
#undef PG8_BAR
#undef PG8_SCHED
}
}
namespace att {
using bf16 = unsigned short;
constexpr int   D = 128, NW = 8, QBLK = 32, KVBLK = 64;
constexpr float SCALE = 0.088388347648318440f;
constexpr float THR = 8.f;
constexpr int SDEPTH = 2;
constexpr int LDQ = 2112, LDK = 576, LDO = 2112;
constexpr size_t SHM_V = KVBLK * D * 2, SHM_K = KVBLK * D * 2, SHM_ATTN = 2 * SHM_V + 2 * SHM_K + NW * 64 * 4;
using bf16x8 = __attribute__((ext_vector_type(8))) short;
using s16x4  = __attribute__((ext_vector_type(4))) short;
using f32x16 = __attribute__((ext_vector_type(16))) float;
using f32x8  = __attribute__((ext_vector_type(8))) float;
using u32x4  = __attribute__((ext_vector_type(4))) unsigned;
#define KSWZ(row, colB) ((row) * 256 + ((colB) ^ (((row) & 7) << 4)))
#define SBAR() __builtin_amdgcn_sched_barrier(0)
__device__ __forceinline__ int crow(int r, int hi) { return (r & 3) + 8 * (r >> 2) + 4 * hi; }
__device__ __forceinline__ unsigned cvtpk(float lo, float hi) {
  unsigned r; asm volatile("v_cvt_pk_bf16_f32 %0, %1, %2" : "=v"(r) : "v"(lo), "v"(hi)); return r;
}
template <typename TIn> struct Stage;
template <> struct Stage<bf16>  { using T = bf16x8;
  __device__ static __forceinline__ T ld8(const bf16* p) { return *reinterpret_cast<const bf16x8*>(p); }
  __device__ static __forceinline__ bf16x8 tobf(T x) { return x; } };
template <> struct Stage<float> { using T = f32x8;
  __device__ static __forceinline__ T ld8(const float* p) { return *reinterpret_cast<const f32x8*>(p); }
  __device__ static __forceinline__ bf16x8 tobf(T x) {
    u32x4 w = {cvtpk(x[0], x[1]), cvtpk(x[2], x[3]), cvtpk(x[4], x[5]), cvtpk(x[6], x[7])}; return *reinterpret_cast<bf16x8*>(&w); } };

__device__ __forceinline__ void partialSM(f32x16& p0, f32x16& p1, float& m_reg, float& mn, float& alpha) {
  constexpr float C = SCALE * 1.4426950408889634f;
  float pmax = p0[0]; for (int r = 1; r < 16; ++r) pmax = fmaxf(pmax, p0[r]); for (int r = 0; r < 16; ++r) pmax = fmaxf(pmax, p1[r]);
  { auto rr = __builtin_amdgcn_permlane32_swap(__float_as_uint(pmax), __float_as_uint(pmax), false, false);
    pmax = fmaxf(__uint_as_float(rr[0]), __uint_as_float(rr[1])); }
  if (__builtin_expect(__all(pmax - m_reg <= THR / SCALE), 1)) { mn = m_reg; alpha = 1.f; }
  else { mn = fmaxf(m_reg, pmax); alpha = __builtin_amdgcn_exp2f((m_reg - mn) * C); m_reg = mn; }
  float mnC = -mn * C;
  for (int r = 0; r < 16; ++r) p0[r] = fmaf(p0[r], C, mnC); for (int r = 0; r < 16; ++r) p1[r] = fmaf(p1[r], C, mnC);
  for (int r = 0; r < 16; ++r) p0[r] = __builtin_amdgcn_exp2f(p0[r]);
}
__device__ __forceinline__ void finishSM(f32x16& p0, f32x16& p1, float alpha, float& l_reg, bf16x8& pa0, bf16x8& pa1, bf16x8& pa2, bf16x8& pa3) {
  for (int r = 0; r < 16; ++r) p1[r] = __builtin_amdgcn_exp2f(p1[r]);
  float ps = 0; for (int r = 0; r < 16; ++r) ps += p0[r]; for (int r = 0; r < 16; ++r) ps += p1[r];
  { auto rr = __builtin_amdgcn_permlane32_swap(__float_as_uint(ps), __float_as_uint(ps), false, false);
    ps = __uint_as_float(rr[0]) + __uint_as_float(rr[1]); }
  l_reg = l_reg * alpha + ps;
#define PK4(P, BASE, OUT) do { unsigned a0 = cvtpk(P[BASE + 0], P[BASE + 1]), a1 = cvtpk(P[BASE + 2], P[BASE + 3]);   \
    unsigned b0 = cvtpk(P[BASE + 4], P[BASE + 5]), b1 = cvtpk(P[BASE + 6], P[BASE + 7]);                              \
    auto r0 = __builtin_amdgcn_permlane32_swap(a0, b0, false, false); auto r1 = __builtin_amdgcn_permlane32_swap(a1, b1, false, false); \
    u32x4 w = {r0[0], r1[0], r0[1], r1[1]}; OUT = *reinterpret_cast<bf16x8*>(&w); } while (0)
  PK4(p0, 0, pa0); PK4(p0, 8, pa1); PK4(p1, 0, pa2); PK4(p1, 8, pa3);
#undef PK4
}
__device__ __forceinline__ void qkt(f32x16& p0, f32x16& p1, const bf16* Ks, const bf16x8* qr, int r32, int hi) {
  p0 = f32x16{}; p1 = f32x16{};
  for (int d0 = 0; d0 < 8; ++d0) { int cb = (d0 * 16 + hi * 8) * 2;
    bf16x8 b0 = *reinterpret_cast<const bf16x8*>((const char*)Ks + KSWZ(r32, cb));
    bf16x8 b1 = *reinterpret_cast<const bf16x8*>((const char*)Ks + KSWZ(32 + r32, cb));
    p0 = __builtin_amdgcn_mfma_f32_32x32x16_bf16(b0, qr[d0], p0, 0, 0, 0);
    p1 = __builtin_amdgcn_mfma_f32_32x32x16_bf16(b1, qr[d0], p1, 0, 0, 0); }
}
__device__ __forceinline__ int v_st(int k, int c) { const int kk = (k & ~0xC) | ((k & 4) << 1) | ((k & 8) >> 1); return ((kk >> 3) * 4 + (c >> 5)) * 512 + ((kk & 7) * 32 + (c & 31)) * 2; }
__device__ __forceinline__ int v_rd_base(int lane) { return ((lane & 3) << 3) | (((lane >> 2) & 3) << 6) | (((lane >> 4) & 1) << 5) | (((lane >> 5) & 1) << 8); }
constexpr int v_rd_off(int d0, int ks, int half) { return d0 * 512 + ks * 4096 + half * 2048; }
template <int OFF> __device__ __forceinline__ s16x4 tr_read(int vb) {
  s16x4 r; asm volatile("ds_read_b64_tr_b16 %0, %1 offset:%2" : "=&v"(r) : "v"(vb), "i"(OFF) : "memory"); return r;
}
template <int D0> __device__ __forceinline__ void pv_one(f32x16& od, int vb, bf16x8 pa0, bf16x8 pa1, bf16x8 pa2, bf16x8 pa3) {
  const s16x4 l0 = tr_read<v_rd_off(D0, 0, 0)>(vb), h0 = tr_read<v_rd_off(D0, 0, 1)>(vb), l1 = tr_read<v_rd_off(D0, 1, 0)>(vb), h1 = tr_read<v_rd_off(D0, 1, 1)>(vb);
  const s16x4 l2 = tr_read<v_rd_off(D0, 2, 0)>(vb), h2 = tr_read<v_rd_off(D0, 2, 1)>(vb), l3 = tr_read<v_rd_off(D0, 3, 0)>(vb), h3 = tr_read<v_rd_off(D0, 3, 1)>(vb);
  asm volatile("s_waitcnt lgkmcnt(0)" ::: "memory"); SBAR();
#define PK(L, H) (bf16x8){L[0], L[1], L[2], L[3], H[0], H[1], H[2], H[3]}
  od = __builtin_amdgcn_mfma_f32_32x32x16_bf16(pa0, PK(l0, h0), od, 0, 0, 0);
  od = __builtin_amdgcn_mfma_f32_32x32x16_bf16(pa1, PK(l1, h1), od, 0, 0, 0);
  od = __builtin_amdgcn_mfma_f32_32x32x16_bf16(pa2, PK(l2, h2), od, 0, 0, 0);
  od = __builtin_amdgcn_mfma_f32_32x32x16_bf16(pa3, PK(l3, h3), od, 0, 0, 0);
#undef PK
}
__device__ __forceinline__ void pv_d0(f32x16* o, int vb, bf16x8 pa0, bf16x8 pa1, bf16x8 pa2, bf16x8 pa3) {
  pv_one<0>(o[0], vb, pa0, pa1, pa2, pa3); pv_one<1>(o[1], vb, pa0, pa1, pa2, pa3); pv_one<2>(o[2], vb, pa0, pa1, pa2, pa3); pv_one<3>(o[3], vb, pa0, pa1, pa2, pa3);
}

template <typename TQ>
__device__ __forceinline__ void attn_dense_body(const TQ* __restrict__ Qb, const bf16* __restrict__ Kh, const bf16* __restrict__ Vh,
                                                bf16* __restrict__ Ob, int seq, char* lds) {
  using St = Stage<bf16>; using SQ = Stage<TQ>;
  const int tid = threadIdx.x, wid = tid >> 6, lane = tid & 63, r32 = lane & 31, hi = lane >> 5;
  bf16* V_lds = (bf16*)lds; bf16* K_lds = (bf16*)(lds + 2 * SHM_V);
  float* ws = (float*)(lds + 2 * SHM_V + 2 * SHM_K) + wid * 64; float* li_l = ws; float* al_l = ws + 32;
  float m_reg = -1e30f, l_reg = 0; f32x16 o[4] = {}; bf16x8 qr[8];
  const TQ* Qw = Qb + (long)(wid * QBLK + r32) * LDQ + hi * 8;
#pragma unroll
  for (int d0 = 0; d0 < 8; ++d0) qr[d0] = SQ::tobf(SQ::ld8(Qw + d0 * 16));
  const int sr = tid >> 4, sc = (tid & 15) * 8, vst0 = v_st(sr, sc), vst1 = v_st(32 + sr, sc);
  const int vb0 = (int)(uintptr_t)V_lds + v_rd_base(lane);
  struct { typename St::T vs0, vs1, ks0, ks1; } sr_[SDEPTH];
#define SLOAD(i, k0) do { sr_[i].vs0 = St::ld8(&Vh[(long)((k0) + sr) * LDK + sc]); sr_[i].vs1 = St::ld8(&Vh[(long)((k0) + 32 + sr) * LDK + sc]); \
    sr_[i].ks0 = St::ld8(&Kh[(long)((k0) + sr) * LDK + sc]); sr_[i].ks1 = St::ld8(&Kh[(long)((k0) + 32 + sr) * LDK + sc]); } while (0)
#define SWRITE(b, i) do { *(bf16x8*)((char*)V_lds + (b) * SHM_V + vst0) = St::tobf(sr_[i].vs0);          \
    *(bf16x8*)((char*)V_lds + (b) * SHM_V + vst1) = St::tobf(sr_[i].vs1); int kc = sc * 2;               \
    *(bf16x8*)((char*)K_lds + (b) * SHM_K + KSWZ(sr, kc)) = St::tobf(sr_[i].ks0);                       \
    *(bf16x8*)((char*)K_lds + (b) * SHM_K + KSWZ(32 + sr, kc)) = St::tobf(sr_[i].ks1); } while (0)
#define SWAIT() do { if constexpr (SDEPTH == 2) asm volatile("s_waitcnt vmcnt(4)" ::: "memory"); else asm volatile("s_waitcnt vmcnt(0)" ::: "memory"); } while (0)
#define RESC(a) do { if (__any((a) < 1.f)) { if (hi == 0) al_l[r32] = (a); asm volatile("s_waitcnt lgkmcnt(0)" ::: "memory"); \
    for (int d = 0; d < 4; ++d) for (int r = 0; r < 16; ++r) o[d][r] *= al_l[crow(r, hi)]; } } while (0)
  f32x16 pA0, pA1, pB0, pB1; float mnA, mnB, alA, alB; bf16x8 pa0, pa1, pa2, pa3; const int NT = seq / KVBLK;
  constexpr int SE = 0, SO = SDEPTH - 1;
  SLOAD(SE, 0); asm volatile("s_waitcnt vmcnt(0)" ::: "memory"); SWRITE(0, SE); __syncthreads();
  qkt(pA0, pA1, K_lds, qr, r32, hi); partialSM(pA0, pA1, m_reg, mnA, alA);
  SLOAD(SO, KVBLK); if constexpr (SDEPTH == 2) { if (2 < NT) SLOAD(SE, 2 * KVBLK); }
  SWAIT(); SWRITE(1, SO); __syncthreads();
  for (int j = 1; j + 1 < NT; j += 2) {
    SBAR(); qkt(pB0, pB1, (bf16*)((char*)K_lds + SHM_K), qr, r32, hi);
    finishSM(pA0, pA1, alA, l_reg, pa0, pa1, pa2, pa3); SBAR();
    SLOAD(SO, (j + SDEPTH) * KVBLK); SBAR();
    pv_d0(o, vb0, pa0, pa1, pa2, pa3); partialSM(pB0, pB1, m_reg, mnB, alB);
    __syncthreads(); SWAIT(); SWRITE(0, SE);
    RESC(alB); __syncthreads();
    SBAR(); qkt(pA0, pA1, K_lds, qr, r32, hi);
    finishSM(pB0, pB1, alB, l_reg, pa0, pa1, pa2, pa3); SBAR();
    SLOAD(SE, ((j + 1 + SDEPTH < NT) ? (j + 1 + SDEPTH) : (NT - 1)) * KVBLK); SBAR();
    pv_d0(o, vb0 + (int)SHM_V, pa0, pa1, pa2, pa3); partialSM(pA0, pA1, m_reg, mnA, alA);
    __syncthreads(); SWAIT(); SWRITE(1, SO);
    RESC(alA); __syncthreads();
  }
  SBAR(); qkt(pB0, pB1, (bf16*)((char*)K_lds + SHM_K), qr, r32, hi);
  finishSM(pA0, pA1, alA, l_reg, pa0, pa1, pa2, pa3); SBAR();
  pv_d0(o, vb0, pa0, pa1, pa2, pa3); partialSM(pB0, pB1, m_reg, mnB, alB);
  __syncthreads(); RESC(alB);
  finishSM(pB0, pB1, alB, l_reg, pa0, pa1, pa2, pa3); SBAR();
  pv_d0(o, vb0 + (int)SHM_V, pa0, pa1, pa2, pa3);
  if (hi == 0) li_l[r32] = l_reg; asm volatile("s_waitcnt lgkmcnt(0)" ::: "memory");
  float rli[16];
#pragma unroll
  for (int r = 0; r < 16; ++r) rli[r] = __builtin_amdgcn_rcpf(li_l[crow(r, hi)]);
  bf16* Ow = Ob + (long)(wid * QBLK) * LDO;
  char* Ot = lds + SHM_ATTN + 1024 + wid * (32 * 272);
#pragma unroll
  for (int r = 0; r < 16; ++r) { int orow = crow(r, hi);
#pragma unroll
    for (int d0 = 0; d0 < 4; ++d0) *(bf16*)(Ot + orow * 272 + (d0 * 32 + r32) * 2) = (bf16)(cvtpk(o[d0][r] * rli[r], 0.f) & 0xffffu); }
  asm volatile("s_waitcnt lgkmcnt(0)" ::: "memory");
#pragma unroll
  for (int j = 0; j < 8; ++j) { const int c = lane + 64 * j, orow = c >> 4, c16 = c & 15;
    *reinterpret_cast<u32x4*>(Ow + (long)orow * LDO + c16 * 8) = *reinterpret_cast<const u32x4*>(Ot + orow * 272 + c16 * 16); }
#undef SLOAD
#undef SWRITE
#undef SWAIT
#undef RESC
}
}
#define XB_TMO      128
#define XB_XCNT(j)  (256  + 64 * (j))
#define XB_XSUB(j)  (1280 + 64 * (j))
#define XB_XGEN(j)  (2304 + 64 * (j))
#define XB_TOP      3328
#define XB_TOPGEN   3392
#define XCD_BAR_WORDS 3456
#define XB_SPIN_CAP (1u << 18)
#define LAS __attribute__((address_space(3)))

__device__ __forceinline__ unsigned xb_ld(unsigned* p)              { return __hip_atomic_load(p, __ATOMIC_RELAXED, __HIP_MEMORY_SCOPE_AGENT); }
__device__ __forceinline__ unsigned xb_add(unsigned* p, unsigned v) { return __hip_atomic_fetch_add(p, v, __ATOMIC_RELAXED, __HIP_MEMORY_SCOPE_AGENT); }
__device__ __forceinline__ unsigned xb_xcc_id() { return (unsigned)__builtin_amdgcn_s_getreg((3 << 11) | 20) & 0xFu; }
#define XB_SPIN(cond, bar) do { unsigned _sp = 0; while (cond) { __builtin_amdgcn_s_sleep(1); \
    if ((++_sp & 255u) == 0u) { if (xb_ld(&(bar)[XB_TMO])) break; if (_sp > XB_SPIN_CAP) { atomicAdd(&(bar)[XB_TMO], 1u); break; } } } } while (0)

struct XcdBarrier {
    unsigned* bar; unsigned x;
    volatile LAS unsigned* st;
};

__device__ __forceinline__ XcdBarrier xcd_barrier_post(unsigned* bar, volatile LAS unsigned* st) {
    XcdBarrier b; b.bar = bar; b.x = xb_xcc_id(); b.st = st;
    if (threadIdx.x == 0) (void)xb_add(&bar[XB_XCNT(b.x)], 1u);
    return b;
}
__device__ __forceinline__ void xcd_barrier_complete(unsigned* bar, unsigned x, unsigned& nloc, unsigned& nx) {
    const unsigned G = gridDim.x * gridDim.y * gridDim.z;
    unsigned sum, cnt, mine, sp = 0u;
    for (;;) {
        sum = 0u; cnt = 0u; mine = 0u;
#pragma unroll
        for (unsigned j = 0; j < 16; ++j) { const unsigned c = xb_ld(&bar[XB_XCNT(j)]); sum += c; cnt += (c > 0u) ? 1u : 0u; mine = (j == x) ? c : mine; }
        if (sum == G) break;
        __builtin_amdgcn_s_sleep(1);
        if ((++sp & 255u) == 0u) { if (xb_ld(&bar[XB_TMO])) break; if (sp > XB_SPIN_CAP) { atomicAdd(&bar[XB_TMO], 1u); break; } }
    }
    nloc = mine > 0u ? mine : 1u; nx = cnt > 0u ? cnt : 1u;
}

__device__ __forceinline__ void xcd_barrier(const XcdBarrier& b) {
    asm volatile("s_waitcnt vmcnt(0)" ::: "memory");
    __syncthreads();
    if (threadIdx.x == 0) {
        unsigned* bar = b.bar;
        __builtin_amdgcn_s_waitcnt(0);
        unsigned nloc = b.st[0], nx = b.st[1];
        if (nloc == 0u) { xcd_barrier_complete(bar, b.x, nloc, nx); b.st[0] = nloc; b.st[1] = nx; }
        const unsigned old = xb_add(&bar[XB_XSUB(b.x)], 1u);
        const unsigned gen = old / nloc;
        if (old + 1u == (gen + 1u) * nloc) {
            __builtin_amdgcn_fence(__ATOMIC_RELEASE, "agent");
            asm volatile("s_waitcnt vmcnt(0)" ::: "memory");
            const unsigned og = xb_add(&bar[XB_TOP], 1u);
            const unsigned tg = og / nx;
            asm volatile("buffer_inv sc1" ::: "memory");
            if (og + 1u == (tg + 1u) * nx) {
#pragma unroll
                for (unsigned j = 0; j < 16; ++j) xb_add(&bar[XB_XGEN(j)], 1u);
            } else XB_SPIN(xb_ld(&bar[XB_XGEN(b.x)]) == gen, bar);
            asm volatile("s_waitcnt vmcnt(0)" ::: "memory");
        } else {
            asm volatile("buffer_inv sc1" ::: "memory");
            XB_SPIN(xb_ld(&bar[XB_XGEN(b.x)]) == gen, bar);
            asm volatile("s_waitcnt vmcnt(0)" ::: "memory");
        }
    }
    __syncthreads();
}

struct Args { const float* in[20]; float* out; unsigned char* ws; int ph_lo, ph_hi, li, pad; };
struct Frame {
    LAS unsigned char* lds; volatile LAS unsigned* MISC;
    int tid, lane, wave, G, vcu, bx;
    unsigned char* ws;
};
enum { IN_X = 0, IN_C, IN_CTX, IN_CCTX, IN_WMOD, IN_BMOD, IN_GMIXPRE, IN_GMIXPOST, IN_GFFNPRE, IN_GFFNPOST, IN_WMIN, IN_BGATE, IN_GHEAD, IN_WMOUT, IN_WQKV, IN_GQ, IN_GK, IN_WAOUT, IN_WFFIN, IN_WFFOUT };

__device__ __forceinline__ void p0_tile(const float* W, int K, int N, bf16_t* WT, int ldw, int mode, LAS unsigned char* scr, int item, int lane) {
    const int nblk = (N + 127) / 128, kb = item / nblk, nb = item % nblk, k0 = 64 * kb, n00 = 128 * nb;
    const int nq = lane & 15, kp = lane >> 4;
    f32x4 va[2][8], vb[2][8];
#pragma unroll
    for (int hf = 0; hf < 2; ++hf) { const int n0 = n00 + 64 * hf;
        const int ncl = (n0 + 4 * nq < N - 4) ? (n0 + 4 * nq) : (N - 4);
        const float* src = W + (size_t)(k0 + 2 * kp) * N + ncl;
#pragma unroll
        for (int i = 0; i < 8; ++i) { va[hf][i] = *(const f32x4*)(src + (size_t)(8 * i) * N); vb[hf][i] = *(const f32x4*)(src + (size_t)(8 * i + 1) * N); } }
    LAS unsigned char* wbase = scr + (4 * nq) * 144 + 4 * kp; const int xs = (nq & 7) << 4;
    const int kc = lane & 7;
#pragma unroll
    for (int hf = 0; hf < 2; ++hf) { const int n0 = n00 + 64 * hf;
        int d0 = n0;
        if (mode == 1) { if (n0 < FF) d0 = 256 * (n0 / 128) + (n0 % 128); else { const int c2 = n0 - FF; d0 = 256 * (c2 / 128) + 128 + (c2 % 128); } }
#pragma unroll
        for (int i = 0; i < 8; ++i) { LAS unsigned char* pi = wbase + ((i << 4) ^ xs);
#pragma unroll
            for (int j = 0; j < 4; ++j) *(LAS unsigned*)(pi + j * 144) = cvtpk2(va[hf][i][j], vb[hf][i][j]); }
        LDS_WAIT(); asm volatile("" ::: "memory");
        v4u ov[8];
#pragma unroll
        for (int jn = 0; jn < 8; ++jn) { const int n = (lane >> 3) + 8 * jn; ov[jn] = *(const LAS v4u*)(scr + n * 144 + ((kc ^ ((n >> 2) & 7)) << 4)); }
#pragma unroll
        for (int jn = 0; jn < 8; ++jn) { const int n = (lane >> 3) + 8 * jn;
            if (n0 + n < N) *(GAS v4u*)(WT + (size_t)(d0 + n) * ldw + k0 + 8 * kc) = ov[jn]; }
        LDS_WAIT(); asm volatile("" ::: "memory");
    }
}

__device__ __forceinline__ void mod_cnd(Frame& F, const Args& a) {
    LAS float* cnd = (LAS float*)F.lds;
    __syncthreads();
    for (int i = F.tid; i < 5 * DM; i += NTHREADS) { const float cv = (i < 4 * DM) ? a.in[IN_C][i] : a.in[IN_CCTX][i - 4 * DM]; cnd[i] = silu_f(cv); }
    __syncthreads();
}
__device__ __forceinline__ void mod_item(Frame& F, const Args& a, int item) {
    const LAS float* cnd = (const LAS float*)F.lds;
    LAS float* red = (LAS float*)(F.lds + 40960);
    int lane = F.lane; asm volatile("" : "+v"(lane));
    const int l = item / 192, c0 = (item % 192) * 64, cq = lane & 15, rg = lane >> 4;
    const float* W = a.in[IN_WMOD] + (size_t)l * DM * NMOD + c0 + (size_t)(F.wave * 256) * NMOD;
    const unsigned lo = (unsigned)(16 * rg * NMOD + cq * 4);
    const LAS float* cl = cnd + F.wave * 256 + 16 * rg;
    f32x4 acc[5];
#pragma unroll
    for (int r = 0; r < 5; ++r) acc[r] = (f32x4){0.f, 0.f, 0.f, 0.f};
#pragma unroll 1
    for (int kk = 0; kk < 256; kk += 64) {
        f32x4 w[16];
#pragma unroll
        for (int i = 0; i < 16; ++i) w[i] = *(const f32x4*)(W + (size_t)(kk + i) * NMOD + lo);
#pragma unroll
        for (int q = 0; q < 4; ++q) {
            f32x4 cv[5];
#pragma unroll
            for (int r = 0; r < 5; ++r) cv[r] = *(const LAS f32x4*)(cl + r * DM + kk + 4 * q);
#pragma unroll
            for (int j = 0; j < 4; ++j)
#pragma unroll
                for (int r = 0; r < 5; ++r) acc[r] = acc[r] + w[4 * q + j] * cv[r][j];
        }
    }
#pragma unroll
    for (int r = 0; r < 5; ++r) *(LAS f32x4*)(red + ((F.wave * 4 + rg) * 5 + r) * 64 + cq * 4) = acc[r];
    __syncthreads();
    for (int o = F.tid; o < 5 * 64; o += NTHREADS) { const int r = o >> 6, n = o & 63; float s = 0.f;
#pragma unroll
        for (int w = 0; w < 32; ++w) s += red[(w * 5 + r) * 64 + n];
        ((float*)(F.ws + WS_MOD))[(size_t)(l * 5 + r) * NMOD + c0 + n] = s + a.in[IN_BMOD][l * NMOD + c0 + n]; }
    __syncthreads();
}
__device__ __forceinline__ void mod_drain(Frame& F, const Args& a, unsigned* ctr, int lo, int hi) {
    mod_cnd(F, a);
    for (;;) {
        if (F.tid == 0) F.MISC[16] = __hip_atomic_fetch_add(ctr, 1u, __ATOMIC_RELAXED, __HIP_MEMORY_SCOPE_AGENT);
        __syncthreads();
        const int it = lo + (int)F.MISC[16];
        __syncthreads();
        if (it >= hi) break;
        mod_item(F, a, it);
    }
}
constexpr int CV_IN = 32 * 49, CV_MO = 32 * 16, CV_QKV = 32 * 24, CV_AO = 32 * 16, CV_FI = 32 * 88, CV_FO = 88 * 16;
constexpr int CV_A0 = CV_IN, CV_B0 = CV_A0 + CV_MO + CV_FI + CV_FO, CV_END = CV_B0 + CV_QKV + CV_AO + CV_FI + CV_FO;
__device__ __forceinline__ void conv_items(Frame& F, const Args& a, unsigned* ctr, int lo, int hi, int grab) {
    unsigned char* ws = F.ws;
    LAS unsigned char* scr = F.lds + F.wave * 9216;
    int lane = F.lane; asm volatile("" : "+v"(lane));
    for (;;) {
        unsigned base = 0u;
        if (lane == 0) base = __hip_atomic_fetch_add(ctr, (unsigned)grab, __ATOMIC_RELAXED, __HIP_MEMORY_SCOPE_AGENT);
        base = (unsigned)__builtin_amdgcn_readfirstlane((int)base);
        if ((int)base >= hi - lo) break;
        for (int it = lo + (int)base; it < lo + (int)base + grab && it < hi; ++it) {
            int r = it;
            const float* W; bf16_t* WT; int K = DM, N, ldw = LDW, mode = 0;
            if (r < CV_IN) { W = a.in[IN_WMIN]; N = MIN_COLS; WT = (bf16_t*)(ws + WS_WIN); }
            else if ((r -= CV_IN) < CV_MO) { W = a.in[IN_WMOUT]; N = DM; WT = (bf16_t*)(ws + WS_WMO); }
            else if ((r -= CV_MO) < CV_FI) { W = a.in[IN_WFFIN]; N = 2 * FF; WT = (bf16_t*)(ws + WS_WFI); mode = 1; }
            else if ((r -= CV_FI) < CV_FO) { W = a.in[IN_WFFOUT]; K = FF; N = DM; WT = (bf16_t*)(ws + WS_WFO); ldw = LDWF; }
            else if ((r -= CV_FO) < CV_QKV) { W = a.in[IN_WQKV]; N = QKV_COLS; WT = (bf16_t*)(ws + WS_WQKV); }
            else if ((r -= CV_QKV) < CV_AO) { W = a.in[IN_WAOUT]; N = DM; WT = (bf16_t*)(ws + WS_WAO); }
            else if ((r -= CV_AO) < CV_FI) { W = a.in[IN_WFFIN] + (size_t)DM * 2 * FF; N = 2 * FF; WT = (bf16_t*)(ws + WS_WFI) + (size_t)2 * FF * LDW; mode = 1; }
            else { r -= CV_FI; W = a.in[IN_WFFOUT] + (size_t)FF * DM; K = FF; N = DM; WT = (bf16_t*)(ws + WS_WFO) + (size_t)DM * LDWF; ldw = LDWF; }
            p0_tile(W, K, N, WT, ldw, mode, scr, r, lane);
        }
    }
    __syncthreads();
}
__device__ __forceinline__ void phase_prep(Frame& F, const Args& a, unsigned* ctr) {
    unsigned char* ws = F.ws;
    if (F.bx < 64 || F.G < 64) { mod_cnd(F, a); for (int it = F.bx; it < 64; it += F.G) mod_item(F, a, it); }
    if (F.bx == F.G - 1) { float* gt = (float*)(ws + WS_ROPE); for (int i = F.tid; i < 64 * 32; i += NTHREADS) { const int pos = i >> 5, f = i & 31; const float inv = powf(10000.0f, -(float)(2 * f) / 64.0f); const float ang = (float)pos * inv; gt[2 * i] = cosf(ang); gt[2 * i + 1] = sinf(ang); } }
    GAS v4u* z = (GAS v4u*)((bf16_t*)(ws + WS_WIN) + (size_t)MIN_COLS * LDW);
    const int nz = (MIN_PAD - MIN_COLS) * LDW / 8;
    for (int i = F.bx * NTHREADS + F.tid; i < nz; i += F.G * NTHREADS) z[i] = (v4u){0u, 0u, 0u, 0u};
    conv_items(F, a, ctr, 0, CV_A0, 1);
}

struct RowCfg { int src_input, has_res, dst, has_h, do_ctx; int l_res, gate_idx; const float* gpost; int l_h, sh_idx, sc_idx; const float* gpre; };
struct RowRegs { f32x4 x[8]; v2u y[8]; };
__device__ __forceinline__ void row_load(RowRegs& r, const float* xrow, const bf16_t* xbrow, const bf16_t* yrow, int lane, int has_res) {
    if (xrow) {
#pragma unroll
        for (int j = 0; j < 8; ++j) r.x[j] = __builtin_nontemporal_load((const f32x4*)(xrow + lane * 4 + 256 * j));
    } else {
#pragma unroll
        for (int j = 0; j < 8; ++j) { const v2u w = __builtin_nontemporal_load((const v2u*)(xbrow + lane * 4 + 256 * j)); r.x[j] = (f32x4){bflo(w.x), bfhi(w.x), bflo(w.y), bfhi(w.y)}; }
    }
    if (has_res) {
#pragma unroll
        for (int j = 0; j < 8; ++j) r.y[j] = __builtin_nontemporal_load((const v2u*)(yrow + lane * 4 + 256 * j));
    }
}
__device__ __forceinline__ void row_compute(RowRegs& r, float* xdst, bf16_t* xbdst, bf16_t* hdst, const LAS float* VA, const LAS float* VB, const LAS float* VC, int lane, const RowCfg& cfg) {
    asm volatile("" ::: "memory");
    if (cfg.has_res) {
        f32x4 y[8]; float ss = 0.f;
#pragma unroll
        for (int j = 0; j < 8; ++j) { const v2u w = r.y[j]; y[j] = (f32x4){bflo(w.x), bfhi(w.x), bflo(w.y), bfhi(w.y)};
            ss += (y[j][0] * y[j][0] + y[j][1] * y[j][1]) + (y[j][2] * y[j][2] + y[j][3] * y[j][3]); }
        const float rstd = rsq_f(wave_sum(ss) * (1.0f / DM) + NORM_EPS);
#pragma unroll
        for (int j = 0; j < 8; ++j) { const f32x4 va = *(const LAS f32x4*)(VA + lane * 4 + 256 * j); r.x[j] = r.x[j] + va * (y[j] * rstd); }
    }
    if (cfg.dst == 2) {
#pragma unroll
        for (int j = 0; j < 8; ++j) __builtin_nontemporal_store(r.x[j], (f32x4*)(xdst + lane * 4 + 256 * j));
    } else if (cfg.dst == 1) {
#pragma unroll
        for (int j = 0; j < 8; ++j) { v2u o; o.x = cvtpk2(r.x[j][0], r.x[j][1]); o.y = cvtpk2(r.x[j][2], r.x[j][3]); __builtin_nontemporal_store(o, (v2u*)(xbdst + lane * 4 + 256 * j));
            r.x[j] = (f32x4){bflo(o.x), bfhi(o.x), bflo(o.y), bfhi(o.y)}; }
    }
    if (cfg.has_h) {
        float ss = 0.f;
#pragma unroll
        for (int j = 0; j < 8; ++j) ss += (r.x[j][0] * r.x[j][0] + r.x[j][1] * r.x[j][1]) + (r.x[j][2] * r.x[j][2] + r.x[j][3] * r.x[j][3]);
        const float rstd = rsq_f(wave_sum(ss) * (1.0f / DM) + NORM_EPS);
#pragma unroll
        for (int j = 0; j < 8; ++j) { const f32x4 vb = *(const LAS f32x4*)(VB + lane * 4 + 256 * j), vc = *(const LAS f32x4*)(VC + lane * 4 + 256 * j);
            const f32x4 h = (r.x[j] * rstd) * vb + vc; v2u o; o.x = cvtpk2(h[0], h[1]); o.y = cvtpk2(h[2], h[3]);
            *(v2u*)(hdst + lane * 4 + 256 * j) = o; }
    }
}
__device__ __forceinline__ void phase_rows(Frame& F, const Args& a, const RowCfg cfg) {
    unsigned char* ws = F.ws;
    const float* MOD = (const float*)(ws + WS_MOD);
    bf16_t* X = (bf16_t*)(ws + WS_X); bf16_t* HA = (bf16_t*)(ws + WS_HA); const bf16_t* Y = (const bf16_t*)(ws + WS_Y);
    LAS float* V = (LAS float*)F.lds;
    for (int blk = F.bx; blk < 256; blk += F.G) {
        const int b = blk >> 6;
        RowRegs r0, r1;
        struct RowRaw { v2u x[8], y[8]; } w0, w1, w2, w3;
#define ROW_LD(RR, Q) do { const int li_ = blk * 64 + F.wave * 8 + (Q); const size_t row_ = (size_t)b * RB + (li_ & 4095); \
            row_load(RR, cfg.src_input ? a.in[IN_X] + (size_t)li_ * DM : nullptr, X + row_ * DM, Y + row_ * LDA2, F.lane, cfg.has_res); } while (0)
#define ROW_CP(RR, Q) do { const int li_ = blk * 64 + F.wave * 8 + (Q); const size_t row_ = (size_t)b * RB + (li_ & 4095); \
            row_compute(RR, a.out + (size_t)li_ * DM, X + row_ * DM, HA + row_ * LDA2, V, V + DM, V + 2 * DM, F.lane, cfg); } while (0)
#define RAW_LD(WW, Q) do { const int li_ = blk * 64 + F.wave * 8 + (Q); const size_t row_ = (size_t)b * RB + (li_ & 4095); \
                _Pragma("unroll") for (int j = 0; j < 8; ++j) { WW.x[j] = __builtin_nontemporal_load((const v2u*)(X + row_ * DM + F.lane * 4 + 256 * j)); WW.y[j] = __builtin_nontemporal_load((const v2u*)(Y + row_ * LDA2 + F.lane * 4 + 256 * j)); } } while (0)
#define RAW_CP(WW, Q) do { _Pragma("unroll") for (int j = 0; j < 8; ++j) { r0.x[j] = (f32x4){bflo(WW.x[j].x), bfhi(WW.x[j].x), bflo(WW.x[j].y), bfhi(WW.x[j].y)}; r0.y[j] = WW.y[j]; } ROW_CP(r0, Q); } while (0)
        const bool cx = cfg.do_ctx && F.wave < 4;
        const int ci = blk * 4 + F.wave; const size_t crow_ = (size_t)b * RB + SEQ + (ci & 255);
        RowRegs rc;
        if (cx) row_load(rc, cfg.src_input ? a.in[IN_CTX] + (size_t)ci * DM : nullptr, X + crow_ * DM, Y + crow_ * LDA2, F.lane, 0);
        if (cfg.src_input) { ROW_LD(r0, 0); } else { RAW_LD(w0, 0); RAW_LD(w1, 1); RAW_LD(w2, 2); }
        __syncthreads();
        for (int set = 0; set < (cfg.do_ctx ? 2 : 1); ++set) {
            const int mr = set ? 4 : b;
            for (int i = F.tid; i < DM; i += NTHREADS) {
                if (cfg.has_res) V[(set * 3 + 0) * DM + i] = MOD[(size_t)(cfg.l_res * 5 + mr) * NMOD + cfg.gate_idx * DM + i] * cfg.gpost[i];
                if (cfg.has_h) { V[(set * 3 + 1) * DM + i] = cfg.gpre[i] * (1.0f + MOD[(size_t)(cfg.l_h * 5 + mr) * NMOD + cfg.sc_idx * DM + i]);
                                 V[(set * 3 + 2) * DM + i] = MOD[(size_t)(cfg.l_h * 5 + mr) * NMOD + cfg.sh_idx * DM + i]; }
            }
        }
        __syncthreads();
        if (cx) {
            if (cfg.has_res) {
                const bf16_t* ys = (const bf16_t*)(ws + WS_YS) + (size_t)ci * LDA2 + F.lane * 4;
#pragma unroll
                for (int j = 0; j < 8; ++j) { f32x4 acc4 = (f32x4){0.f, 0.f, 0.f, 0.f};
#pragma unroll
                    for (int sl = 0; sl < 4; ++sl) { const v2u w = *(const v2u*)(ys + (size_t)sl * 1024 * LDA2 + 256 * j); acc4 = acc4 + (f32x4){bflo(w.x), bfhi(w.x), bflo(w.y), bfhi(w.y)}; }
                    rc.y[j].x = cvtpk2(acc4[0], acc4[1]); rc.y[j].y = cvtpk2(acc4[2], acc4[3]); } }
            row_compute(rc, nullptr, X + crow_ * DM, HA + crow_ * LDA2, V + 3 * DM, V + 4 * DM, V + 5 * DM, F.lane, cfg); }
        if (cfg.src_input) {
            for (int q = 0; q < 8; q += 2) {
                ROW_LD(r1, q + 1);
                ROW_CP(r0, q);
                if (q + 2 < 8) ROW_LD(r0, q + 2);
                ROW_CP(r1, q + 1);
            }
        } else {
            RAW_LD(w3, 3); RAW_CP(w0, 0);
            RAW_LD(w0, 4); RAW_CP(w1, 1);
            RAW_LD(w1, 5); RAW_CP(w2, 2);
            RAW_LD(w2, 6); RAW_CP(w3, 3);
            RAW_LD(w3, 7); RAW_CP(w0, 4);
            RAW_CP(w1, 5); RAW_CP(w2, 6); RAW_CP(w3, 7);
        }
#undef RAW_LD
#undef RAW_CP
#undef ROW_LD
#undef ROW_CP
    }
    __syncthreads();
}

__device__ __forceinline__ float half_sum32(float v, int lane) { v = row_sum16(v); const float lo = rl_f(v, 0) + rl_f(v, 16), hi = rl_f(v, 32) + rl_f(v, 48); return (lane & 32) ? hi : lo; }
struct HnRegs { v4u f[4], b[4], o[4]; };
__device__ __forceinline__ void hn_load(HnRegs& r, const bf16_t* HFp, const bf16_t* HBp, const bf16_t* PRJ, size_t row, int lane) {
#pragma unroll
    for (int j = 0; j < 4; ++j) { const int col = j * 512 + lane * 8;
        r.f[j] = *(const v4u*)(HFp + row * LDA2 + col); r.b[j] = *(const v4u*)(HBp + row * LDA2 + col); r.o[j] = *(const v4u*)(PRJ + row * PRJ_LD + 4096 + col); }
}
__device__ __forceinline__ void hn_compute(const HnRegs& r, bf16_t* HO, int ldo, const float* gh, size_t row, int lane) {
#pragma unroll
    for (int j = 0; j < 4; ++j) { const int col = j * 512 + lane * 8;
        float h[8]; float ss = 0.f;
#pragma unroll
        for (int e = 0; e < 4; ++e) { h[2 * e] = bflo(r.f[j][e]) + bflo(r.b[j][e]); h[2 * e + 1] = bfhi(r.f[j][e]) + bfhi(r.b[j][e]); ss += h[2 * e] * h[2 * e] + h[2 * e + 1] * h[2 * e + 1]; }
        const float rstd = 1.0f / sqrtf(half_sum32(ss, lane) * (1.0f / 256.0f) + NORM_EPS);
        const f32x4 g0 = *(const f32x4*)(gh + col), g1 = *(const f32x4*)(gh + col + 4);
        v4u w;
#pragma unroll
        for (int e = 0; e < 4; ++e) { const float ga = (e < 2) ? g0[2 * e] : g1[2 * e - 4], gb = (e < 2) ? g0[2 * e + 1] : g1[2 * e - 3];
            w[e] = cvtpk2(h[2 * e] * rstd * ga * bflo(r.o[j][e]), h[2 * e + 1] * rstd * gb * bfhi(r.o[j][e])); }
        *(v4u*)(HO + row * ldo + col) = w; }
}
__device__ __forceinline__ void phase_headnorm_ctx(Frame& F, const Args& a, bf16_t* HO, int ldo) {
    unsigned char* ws = F.ws;
    const bf16_t* HFp = (const bf16_t*)(ws + WS_HF); const bf16_t* HBp = (const bf16_t*)(ws + WS_HB); const bf16_t* PRJ = (const bf16_t*)(ws + WS_PRJ);
    const float* gh = a.in[IN_GHEAD];
    const int gw = F.bx * NWAVES + F.wave, NGW = F.G * NWAVES;
    for (int ci = gw; ci < BATCH * CTXL; ci += NGW) {
        const size_t row = (size_t)(ci >> 8) * RB + SEQ + (ci & 255);
        HnRegs r0;
        hn_load(r0, HFp, HBp, PRJ, row, F.lane);
        hn_compute(r0, HO, ldo, gh, row, F.lane);
    }
    __syncthreads();
}

__device__ __forceinline__ float sum16(float v) { return row_sum16(v); }
struct QkRegs { v4u q[4]; v4u k; };
__device__ __forceinline__ void qk_load(QkRegs& r, const bf16_t* Q1, const bf16_t* K1, size_t row, int lane, bool lat) {
    const int hg = lane >> 4, e0 = (lane & 15) * 8;
    if (lat) {
#pragma unroll
        for (int j = 0; j < 4; ++j) r.q[j] = *(const v4u*)(Q1 + row * LDA2 + (4 * j + hg) * 128 + e0);
    }
    r.k = *(const v4u*)(K1 + row * LDKV + hg * 128 + e0);
}
__device__ __forceinline__ v4u qk_norm_rope(const v4u w, const float (&g)[8], const float (&cs)[4], const float (&sn)[4]) {
    float x[8]; float ss = 0.f;
#pragma unroll
    for (int e = 0; e < 4; ++e) { x[2 * e] = bflo(w[e]); x[2 * e + 1] = bfhi(w[e]); ss += x[2 * e] * x[2 * e] + x[2 * e + 1] * x[2 * e + 1]; }
    const float rstd = 1.0f / sqrtf(sum16(ss) * (1.0f / 128.0f) + NORM_EPS);
    v4u o;
#pragma unroll
    for (int e = 0; e < 4; ++e) { const float x0 = x[2 * e] * rstd * g[2 * e], x1 = x[2 * e + 1] * rstd * g[2 * e + 1];
        o[e] = cvtpk2(x0 * cs[e] - x1 * sn[e], x0 * sn[e] + x1 * cs[e]); }
    return o;
}
__device__ __forceinline__ void qk_compute(const QkRegs& r, bf16_t* Q1, bf16_t* K1, size_t row, int lane, bool lat, int t, const LAS float* tab, const float (&gq)[8], const float (&gk)[8]) {
    const int hg = lane >> 4, e0 = (lane & 15) * 8;
    float cs[4], sn[4];
#pragma unroll
    for (int p = 0; p < 4; ++p) { cs[p] = 1.f; sn[p] = 0.f; }
    if (lat) {
        const int i0 = e0 >> 1; const int pos = (i0 < 32) ? (t >> 6) : (t & 63); const int f0 = i0 & 31;
#pragma unroll
        for (int p = 0; p < 4; ++p) { cs[p] = tab[(pos * 32 + f0 + p) * 2]; sn[p] = tab[(pos * 32 + f0 + p) * 2 + 1]; }
#pragma unroll
        for (int j = 0; j < 4; ++j) *(v4u*)(Q1 + row * LDA2 + (4 * j + hg) * 128 + e0) = qk_norm_rope(r.q[j], gq, cs, sn);
    }
    *(v4u*)(K1 + row * LDKV + hg * 128 + e0) = qk_norm_rope(r.k, gk, cs, sn);
}
__device__ __forceinline__ void phase_qknorm(Frame& F, const Args& a) {
    unsigned char* ws = F.ws;
    bf16_t* Q1 = (bf16_t*)(ws + WS_Q1); bf16_t* K1 = (bf16_t*)(ws + WS_K1);
    float gq[8], gk[8];
    { const int e0 = (F.lane & 15) * 8;
#pragma unroll
      for (int e = 0; e < 8; ++e) { gq[e] = a.in[IN_GQ][e0 + e]; gk[e] = a.in[IN_GK][e0 + e]; } }
    const int gw = F.bx * NWAVES + F.wave, NGW = F.G * NWAVES;
    for (int ci = gw; ci < BATCH * CTXL; ci += NGW) {
        const bf16_t* qs = (const bf16_t*)(ws + WS_QS) + (size_t)ci * 1024 + F.lane * 8;
        float ka[8], va[8];
#pragma unroll
        for (int e = 0; e < 8; ++e) { ka[e] = 0.f; va[e] = 0.f; }
#pragma unroll
        for (int sl = 0; sl < 8; ++sl) { const v4u wk = *(const v4u*)(qs + (size_t)sl * 1024 * 1024), wv = *(const v4u*)(qs + (size_t)sl * 1024 * 1024 + 512);
#pragma unroll
            for (int e = 0; e < 4; ++e) { ka[2 * e] += bflo(wk[e]); ka[2 * e + 1] += bfhi(wk[e]); va[2 * e] += bflo(wv[e]); va[2 * e + 1] += bfhi(wv[e]); } }
        float ss = 0.f;
#pragma unroll
        for (int e = 0; e < 8; ++e) ss += ka[e] * ka[e];
        const float rstd = 1.0f / sqrtf(sum16(ss) * (1.0f / 128.0f) + NORM_EPS);
        const size_t row = (size_t)(ci >> 8) * RB + SEQ + (ci & 255);
        v4u ok, ov;
#pragma unroll
        for (int e = 0; e < 4; ++e) { ok[e] = cvtpk2(ka[2 * e] * rstd * gk[2 * e], ka[2 * e + 1] * rstd * gk[2 * e + 1]); ov[e] = cvtpk2(va[2 * e], va[2 * e + 1]); }
        *(v4u*)(K1 + row * LDKV + F.lane * 8) = ok; *(v4u*)((bf16_t*)(ws + WS_V1) + row * LDKV + F.lane * 8) = ov;
    }
    __syncthreads();
}

__device__ __forceinline__ void phase_scan_naive(Frame& F, const Args& a) {
    unsigned char* ws = F.ws;
    const bf16_t* PRJ = (const bf16_t*)(ws + WS_PRJ); const float* GATES = (const float*)(ws + WS_GATES);
    LAS float* Qs = (LAS float*)F.lds;
    LAS float* Ks = Qs + 64 * 129;
    LAS float* Vs = Ks + 64 * 129;
    LAS float* Ps = Vs + 64 * 65;
    LAS float* Cs = Ps + 64 * 65;
    LAS float* ns = Cs + 128 * 65;
    LAS float* gs = ns + 128;
    const int tid = F.tid;
    for (int item = F.bx; item < 256; item += F.G) {
        const int vs = item & 3, dir = (item >> 2) & 1, hh = (item >> 3) & 7, b = item >> 6;
        bf16_t* HO = (bf16_t*)(ws + (dir ? WS_HB : WS_HF));
        __syncthreads();
        for (int i = tid; i < 128 * 65; i += NTHREADS) Cs[i] = 0.f;
        if (tid < 128) ns[tid] = 0.f;
        float mprev = 0.f;
        for (int step = 0; step < 68; ++step) {
            const bool isctx = step < 4; const int cj = isctx ? (dir ? 3 - step : step) : (dir ? 63 - (step - 4) : step - 4);
            const size_t rbase = (size_t)b * RB + (isctx ? SEQ : 0) + 64 * cj;
            __syncthreads();
            for (int i = tid; i < 64 * 64; i += NTHREADS) { const int p = i >> 6, c2 = i & 63; const size_t row = rbase + (dir ? 63 - p : p);
                const unsigned wq = *(const unsigned*)(PRJ + row * PRJ_LD + hh * 128 + 2 * c2), wk = *(const unsigned*)(PRJ + row * PRJ_LD + 1024 + hh * 128 + 2 * c2);
                Qs[p * 129 + 2 * c2] = bflo(wq); Qs[p * 129 + 2 * c2 + 1] = bfhi(wq); Ks[p * 129 + 2 * c2] = bflo(wk); Ks[p * 129 + 2 * c2 + 1] = bfhi(wk); }
            for (int i = tid; i < 64 * 32; i += NTHREADS) { const int p = i >> 5, c2 = i & 31; const size_t row = rbase + (dir ? 63 - p : p);
                const unsigned wv = *(const unsigned*)(PRJ + row * PRJ_LD + 2048 + hh * 256 + vs * 64 + 2 * c2);
                Vs[p * 65 + 2 * c2] = bflo(wv); Vs[p * 65 + 2 * c2 + 1] = bfhi(wv); }
            if (tid < 64) { const size_t row = rbase + (dir ? 63 - tid : tid); gs[tid] = GATES[row * 32 + dir * 16 + hh]; gs[64 + tid] = GATES[row * 32 + dir * 16 + 8 + hh]; }
            __syncthreads();
            if (tid < 64) {
                float bc = 0.f; for (int r = 0; r <= tid; ++r) bc += gs[64 + r];
                gs[128 + tid] = bc; gs[192 + tid] = gs[tid] - bc;
            }
            __syncthreads();
            if (tid < 64) {
                float amax = -3.0e38f; for (int s = 0; s <= tid; ++s) amax = fmaxf(amax, gs[192 + s]);
                const float bc = gs[128 + tid];
                const float mt = fmaxf(bc + mprev, bc + amax);
                gs[256 + tid] = mt; gs[320 + tid] = expf(bc + mprev - mt);
            }
            float bend, mnew, decay;
            {
                bend = gs[128 + 63]; float amax = -3.0e38f; for (int s = 0; s < 64; ++s) amax = fmaxf(amax, gs[192 + s]);
                mnew = fmaxf(bend + mprev, bend + amax); decay = expf(bend + mprev - mnew);
            }
            if (tid < 64) gs[384 + tid] = expf(bend + gs[192 + tid] - mnew);
            __syncthreads();
            {
                const int t = tid >> 3, s0 = (tid & 7) * 8; float acc[8];
#pragma unroll
                for (int j = 0; j < 8; ++j) acc[j] = 0.f;
                for (int d = 0; d < 128; ++d) { const float qv = Qs[t * 129 + d];
#pragma unroll
                    for (int j = 0; j < 8; ++j) acc[j] += qv * Ks[(s0 + j) * 129 + d]; }
                const float bt = gs[128 + t], mt = gs[256 + t];
#pragma unroll
                for (int j = 0; j < 8; ++j) { const int s = s0 + j; Ps[t * 65 + s] = (s <= t) ? acc[j] * expf(bt + gs[192 + s] - mt) : 0.f; }
            }
            __syncthreads();
            {
                const int t = tid >> 3, v0 = (tid & 7) * 8; float num[8], c2[8]; float den = 0.f, qn = 0.f;
#pragma unroll
                for (int j = 0; j < 8; ++j) { num[j] = 0.f; c2[j] = 0.f; }
                for (int s = 0; s < 64; ++s) { const float pv = Ps[t * 65 + s]; den += pv;
#pragma unroll
                    for (int j = 0; j < 8; ++j) num[j] += pv * Vs[s * 65 + v0 + j]; }
                for (int d = 0; d < 128; ++d) { const float qv = Qs[t * 129 + d]; qn += qv * ns[d];
#pragma unroll
                    for (int j = 0; j < 8; ++j) c2[j] += qv * Cs[d * 65 + v0 + j]; }
                const float inter = gs[320 + t], mt = gs[256 + t];
                den += inter * qn;
                const float dn = 1.0f / fmaxf(fabsf(den), expf(-mt));
                const size_t row = rbase + (dir ? 63 - t : t);
                v4u o; float hv[8];
#pragma unroll
                for (int j = 0; j < 8; ++j) hv[j] = (num[j] + inter * c2[j]) * dn;
                o.x = pk2(hv[0], hv[1]); o.y = pk2(hv[2], hv[3]); o.z = pk2(hv[4], hv[5]); o.w = pk2(hv[6], hv[7]);
                *(v4u*)(HO + row * LDA2 + hh * 256 + vs * 64 + v0) = o;
            }
            __syncthreads();
            {
                const int d = tid >> 2, v0 = (tid & 3) * 16; float acc[16]; float nacc = 0.f;
#pragma unroll
                for (int j = 0; j < 16; ++j) acc[j] = 0.f;
                for (int s = 0; s < 64; ++s) { const float kw = gs[384 + s] * Ks[s * 129 + d]; nacc += kw;
#pragma unroll
                    for (int j = 0; j < 16; ++j) acc[j] += kw * Vs[s * 65 + v0 + j]; }
#pragma unroll
                for (int j = 0; j < 16; ++j) Cs[d * 65 + v0 + j] = decay * Cs[d * 65 + v0 + j] + acc[j];
                if ((tid & 3) == 0) ns[d] = decay * ns[d] + nacc;
            }
            mprev = mnew;
        }
    }
    __syncthreads();
}

typedef short sbf16x8 __attribute__((ext_vector_type(8)));
typedef float sf32x16 __attribute__((ext_vector_type(16)));
#define MFMA32(a, b, c) __builtin_amdgcn_mfma_f32_32x32x16_bf16((a), (b), (c), 0, 0, 0)
constexpr int SC_QP = 272, SC_TP = 144, SC_CP = 272;
constexpr int SC_Q = 0, SC_K = SC_Q + 64 * SC_QP, SC_KT = SC_K + 64 * SC_QP, SC_VT = SC_KT + 2 * 128 * SC_TP, SC_CT = SC_VT + 2 * 64 * SC_TP, SC_P = SC_CT + 96 * SC_CP, SC_PS = SC_P + 64 * SC_TP, SC_GS = SC_PS + 512, SC_END = SC_GS + 8 * 1280;
static_assert(SC_END <= MISC_OFF, "scan LDS");
__device__ __forceinline__ unsigned pk_lo(unsigned a, unsigned b) { return (a & 0xffffu) | (b << 16); }
__device__ __forceinline__ unsigned pk_hi(unsigned a, unsigned b) { return (a >> 16) | (b & 0xffff0000u); }
#define SC_LBAR() do { asm volatile("s_waitcnt lgkmcnt(0)" ::: "memory"); __builtin_amdgcn_s_barrier(); asm volatile("" ::: "memory"); } while (0)

struct ScStage { v4u q0, q1, k0, k1, v0; float gi, gf; };
struct ScGate { float bc, av, am, bend, amall; };
struct ScCtx { const bf16_t* PRJ; const float* GATES; bf16_t* HO; LAS unsigned char* lds; LAS float* g; int b, hh, vs, dir, lane, wave, r, h, grow, sgn; unsigned okm; };

__device__ __forceinline__ size_t sc_rbase(const ScCtx& c, int st) { return (size_t)c.b * RB + ((st < 4) ? (SEQ + 64 * (c.dir ? 3 - st : st)) : 64 * (c.dir ? 63 - (st - 4) : st - 4)); }
__device__ __forceinline__ void sc_load(const ScCtx& c, int st, ScStage& s) {
    const size_t rb = sc_rbase(c, st); const int row = 8 * c.wave + (c.lane >> 3), ch = c.lane & 7;
    const bf16_t* p0 = c.PRJ + (rb + row) * PRJ_LD + c.hh * 128 + ch * 8;
    s.q0 = *(const v4u*)p0; s.q1 = *(const v4u*)(p0 + 64); s.k0 = *(const v4u*)(p0 + 1024); s.k1 = *(const v4u*)(p0 + 1024 + 64);
    s.v0 = *(const v4u*)(c.PRJ + (rb + row) * PRJ_LD + 2048 + c.hh * 256 + c.vs * 64 + ch * 8);
    s.gi = c.GATES[(rb + c.grow) * 32 + c.dir * 16 + c.hh]; s.gf = c.GATES[(rb + c.grow) * 32 + c.dir * 16 + 8 + c.hh];
}
__device__ __forceinline__ int sc_troff(int trow, int kchunk) { return trow * SC_TP + ((kchunk ^ ((trow >> 3) & 7)) << 4); }
template <int CTRL> __device__ __forceinline__ unsigned sc_dppu(unsigned old, unsigned src) { return (unsigned)__builtin_amdgcn_update_dpp((int)old, (int)src, CTRL, 0xf, 0xf, false); }
__device__ __forceinline__ void sc_tr_write(LAS unsigned char* T, const v4u w, int row, int c0, int lane) {
    const bool hi = (lane >> 3) & 1;
    unsigned r0 = sc_dppu<0x108>(0u, w[0]), r1 = sc_dppu<0x108>(0u, w[1]);
    r0 = sc_dppu<0x118>(r0, w[2]); r1 = sc_dppu<0x118>(r1, w[3]);
    const unsigned a0 = hi ? r0 : w[0], a1 = hi ? r1 : w[1], b0 = hi ? w[2] : r0, b1 = hi ? w[3] : r1;
    LAS unsigned char* p = T + (c0 + (hi ? 4 : 0)) * SC_TP + ((((row >> 3) ^ (c0 >> 3)) & 7) << 4) + 2 * (row & 6);
    *(LAS unsigned*)(p) = pk_lo(a0, b0); *(LAS unsigned*)(p + SC_TP) = pk_hi(a0, b0); *(LAS unsigned*)(p + 2 * SC_TP) = pk_lo(a1, b1); *(LAS unsigned*)(p + 3 * SC_TP) = pk_hi(a1, b1);
}
__device__ __forceinline__ void sc_write(const ScCtx& c, const ScStage& s, int buf) {
    LAS unsigned char* lds = c.lds; const int row = 8 * c.wave + (c.lane >> 3), ch = c.lane & 7;
    *(LAS v4u*)(lds + SC_Q + row * SC_QP + ch * 16) = s.q0; *(LAS v4u*)(lds + SC_Q + row * SC_QP + (ch + 8) * 16) = s.q1;
    *(LAS v4u*)(lds + SC_K + row * SC_QP + ch * 16) = s.k0; *(LAS v4u*)(lds + SC_K + row * SC_QP + (ch + 8) * 16) = s.k1;
    LAS unsigned char* kt = lds + SC_KT + buf * 128 * SC_TP; LAS unsigned char* vt = lds + SC_VT + buf * 64 * SC_TP;
    sc_tr_write(kt, s.k0, row, ch * 8, c.lane); sc_tr_write(kt, s.k1, row, 64 + ch * 8, c.lane); sc_tr_write(vt, s.v0, row, ch * 8, c.lane);
}
template <int CTRL, int ROWMASK> __device__ __forceinline__ float sc_dpp(float old, float src) {
    return __builtin_bit_cast(float, __builtin_amdgcn_update_dpp(__builtin_bit_cast(int, old), __builtin_bit_cast(int, src), CTRL, ROWMASK, 0xf, false)); }
__device__ __forceinline__ void sc_gate(const ScCtx& c, float gi, float gf, ScGate& o) {
    float bc = gf;
    bc += sc_dpp<0x111, 0xf>(0.f, bc); bc += sc_dpp<0x112, 0xf>(0.f, bc); bc += sc_dpp<0x114, 0xf>(0.f, bc); bc += sc_dpp<0x118, 0xf>(0.f, bc);
    bc += sc_dpp<0x142, 0xa>(0.f, bc); bc += sc_dpp<0x143, 0xc>(0.f, bc);
    const float av = gi - bc;
    const float NI = -3.0e38f;
    float am = av;
    am = fmaxf(am, sc_dpp<0x111, 0xf>(NI, am)); am = fmaxf(am, sc_dpp<0x112, 0xf>(NI, am)); am = fmaxf(am, sc_dpp<0x114, 0xf>(NI, am)); am = fmaxf(am, sc_dpp<0x118, 0xf>(NI, am));
    am = fmaxf(am, sc_dpp<0x142, 0xa>(NI, am)); am = fmaxf(am, sc_dpp<0x143, 0xc>(NI, am));
    o.bc = bc; o.av = av; o.am = am;
    o.bend = __builtin_bit_cast(float, __builtin_amdgcn_readlane(__builtin_bit_cast(int, bc), 63)); o.amall = __builtin_bit_cast(float, __builtin_amdgcn_readlane(__builtin_bit_cast(int, am), 63));
}
__device__ __forceinline__ void sc_table(const ScCtx& c, const ScGate& cur, float& mprev, int par) {
    LAS float* g = c.g + par * 384;
    const float mt = cur.bc + fmaxf(mprev, cur.am);
    const float mnew = cur.bend + fmaxf(mprev, cur.amall), decay = __expf(cur.bend + mprev - mnew);
    const int gr = c.grow;
    g[gr] = cur.av; g[64 + gr] = cur.bc - mt; g[128 + gr] = __expf(cur.bc + mprev - mt); g[192 + gr] = __expf(-mt); g[256 + gr] = __expf(cur.bend + cur.av - mnew);
    if (c.lane == 0) g[320] = decay;
    mprev = mnew;
}
template <int V> __device__ __forceinline__ void sc_step(const ScCtx& c, int step, ScStage& ld, const ScStage& wr, ScGate& cur, float& mprev, sf32x16 (&accC)[3]) {
    LAS unsigned char* lds = c.lds; LAS float* g = c.g + (step & 1) * 384;
    const int wave = c.wave, r = c.r, h = c.h, buf = step & 1;
    const size_t rbase = sc_rbase(c, step);
    if (V == 0 || V == 4) sc_load(c, step + 2 < 68 ? step + 2 : 67, ld);
    LAS unsigned char* kt = lds + SC_KT + buf * 128 * SC_TP; LAS unsigned char* vt = lds + SC_VT + buf * 64 * SC_TP;
    if (V < 2 && wave >= 4) {
        const int sb = (wave - 4) >> 1, tb = (wave - 4) & 1, t = 32 * tb + r;
        sf32x16 x0, x1;
#pragma unroll
        for (int i = 0; i < 16; ++i) { x0[i] = 0.f; x1[i] = 0.f; }
        const bool live = c.sgn * (sb - tb) <= 0;
        const float bm_t = g[64 + t];
        if (live) {
#pragma unroll
            for (int kh = 0; kh < 8; kh += 4) {
                sbf16x8 kfr[4], qfr[4];
#pragma unroll
                for (int k2 = 0; k2 < 4; ++k2) { const int ks = kh + k2; kfr[k2] = *(const LAS sbf16x8*)(lds + SC_K + (32 * sb + r) * SC_QP + (16 * ks + 8 * h) * 2); qfr[k2] = *(const LAS sbf16x8*)(lds + SC_Q + t * SC_QP + (16 * ks + 8 * h) * 2); }
                __builtin_amdgcn_sched_barrier(0);
                x0 = MFMA32(kfr[0], qfr[0], x0); x1 = MFMA32(kfr[1], qfr[1], x1); x0 = MFMA32(kfr[2], qfr[2], x0); x1 = MFMA32(kfr[3], qfr[3], x1);
            }
        }
        float psum = 0.f;
#pragma unroll
        for (int gq = 0; gq < 4; ++gq) {
            const f32x4 a4 = *(const LAS f32x4*)(g + 32 * sb + 8 * gq + 4 * h);
            float p[4];
#pragma unroll
            for (int i = 0; i < 4; ++i) { const bool ok = (c.okm >> (4 * gq + i)) & 1u; p[i] = ok ? (x0[4 * gq + i] + x1[4 * gq + i]) * __expf(bm_t + a4[i]) : 0.f; psum += p[i]; }
            v2u w; w.x = cvtpk2(p[0], p[1]); w.y = cvtpk2(p[2], p[3]);
            *(LAS v2u*)(lds + SC_P + t * SC_TP + (32 * sb + 8 * gq + 4 * h) * 2) = w;
        }
        psum += __shfl_xor(psum, 32);
        if (h == 0) *(LAS float*)(lds + SC_PS + (sb * 64 + t) * 4) = psum;
    }
    sf32x16 (&aq) = accC[0]; sf32x16 (&ad) = accC[1];
    const int otb = wave >> 1, ovb = wave & 1, ot = 32 * otb + r;
    if (V < 2 && wave < 4) {
#pragma unroll
        for (int i = 0; i < 16; ++i) { aq[i] = 0.f; ad[i] = 0.f; }
#pragma unroll
        for (int kh = 0; kh < 8; kh += 4) {
            sbf16x8 qf[4], cf[4], nf[4];
#pragma unroll
            for (int k2 = 0; k2 < 4; ++k2) { const int ks = kh + k2;
                qf[k2] = *(const LAS sbf16x8*)(lds + SC_Q + ot * SC_QP + (16 * ks + 8 * h) * 2);
                cf[k2] = *(const LAS sbf16x8*)(lds + SC_CT + (32 * ovb + r) * SC_CP + (16 * ks + 8 * h) * 2);
                nf[k2] = *(const LAS sbf16x8*)(lds + SC_CT + (64 + r) * SC_CP + (16 * ks + 8 * h) * 2); }
            __builtin_amdgcn_sched_barrier(0);
#pragma unroll
            for (int k2 = 0; k2 < 4; ++k2) { aq = MFMA32(cf[k2], qf[k2], aq); ad = MFMA32(nf[k2], qf[k2], ad); }
        }
    }
    SC_LBAR();
    if (V >= 2) {} else if (wave >= 4) {
        const int db = wave - 4;
        { const float decay = g[320];
#pragma unroll
        for (int n = 0; n < 3; ++n) accC[n] = accC[n] * decay; }
        const sbf16x8 onesf = (r == 0) ? (sbf16x8){0x3F80, 0x3F80, 0x3F80, 0x3F80, 0x3F80, 0x3F80, 0x3F80, 0x3F80} : (sbf16x8){0, 0, 0, 0, 0, 0, 0, 0};
#pragma unroll
        for (int kh = 0; kh < 4; kh += 2) {
        sbf16x8 kfa[2], v0a[2], v1a[2]; f32x4 w0a[2], w1a[2];
#pragma unroll
        for (int k2 = 0; k2 < 2; ++k2) { const int ks = kh + k2; kfa[k2] = *(const LAS sbf16x8*)(kt + sc_troff(32 * db + r, 2 * ks + h));
            w0a[k2] = *(const LAS f32x4*)(g + 256 + 16 * ks + 8 * h); w1a[k2] = *(const LAS f32x4*)(g + 256 + 16 * ks + 8 * h + 4);
            v0a[k2] = *(const LAS sbf16x8*)(vt + sc_troff(r, 2 * ks + h)); v1a[k2] = *(const LAS sbf16x8*)(vt + sc_troff(32 + r, 2 * ks + h)); }
        __builtin_amdgcn_sched_barrier(0);
#pragma unroll
        for (int k2 = 0; k2 < 2; ++k2) {
            const sbf16x8 kf = kfa[k2];
            const f32x4 w0 = w0a[k2], w1 = w1a[k2];
            v4u kw;
            kw.x = cvtpk2(bf2f((unsigned short)kf[0]) * w0[0], bf2f((unsigned short)kf[1]) * w0[1]); kw.y = cvtpk2(bf2f((unsigned short)kf[2]) * w0[2], bf2f((unsigned short)kf[3]) * w0[3]);
            kw.z = cvtpk2(bf2f((unsigned short)kf[4]) * w1[0], bf2f((unsigned short)kf[5]) * w1[1]); kw.w = cvtpk2(bf2f((unsigned short)kf[6]) * w1[2], bf2f((unsigned short)kf[7]) * w1[3]);
            const sbf16x8 kwf = __builtin_bit_cast(sbf16x8, kw);
            const sbf16x8 v0f = v0a[k2], v1f = v1a[k2];
            accC[0] = MFMA32(kwf, v0f, accC[0]); accC[1] = MFMA32(kwf, v1f, accC[1]); accC[2] = MFMA32(kwf, onesf, accC[2]);
        }
        }
#pragma unroll
        for (int n = 0; n < 3; ++n)
#pragma unroll
            for (int gq = 0; gq < 4; ++gq) { v2u w; w.x = cvtpk2(accC[n][4 * gq], accC[n][4 * gq + 1]); w.y = cvtpk2(accC[n][4 * gq + 2], accC[n][4 * gq + 3]);
                *(LAS v2u*)(lds + SC_CT + (32 * n + r) * SC_CP + (32 * db + 8 * gq + 4 * h) * 2) = w; }
    } else {
        sf32x16 (&an) = accC[2];
#pragma unroll
        for (int i = 0; i < 16; ++i) an[i] = 0.f;
        sbf16x8 vfa[4], pfa[4];
#pragma unroll
        for (int ks = 0; ks < 4; ++ks) { vfa[ks] = *(const LAS sbf16x8*)(vt + sc_troff(32 * ovb + r, 2 * ks + h)); pfa[ks] = *(const LAS sbf16x8*)(lds + SC_P + ot * SC_TP + (16 * ks + 8 * h) * 2); }
        const float inter_t = g[128 + ot], enm_t = g[192 + ot];
        const float ps = *(const LAS float*)(lds + SC_PS + ot * 4) + *(const LAS float*)(lds + SC_PS + (64 + ot) * 4);
        __builtin_amdgcn_sched_barrier(0);
#pragma unroll
        for (int ks = 0; ks < 4; ++ks) an = MFMA32(vfa[ks], pfa[ks], an);
        const float dq = __shfl(ad[0], r);
        const float den = ps + inter_t * dq;
        const float dn = rcp_f(fmaxf(fabsf(den), enm_t));
        bf16_t* op = c.HO + (rbase + ot) * LDA2 + c.hh * 256 + c.vs * 64 + 32 * ovb + 4 * h;
#pragma unroll
        for (int gq = 0; gq < 4; ++gq) { float o[4];
#pragma unroll
            for (int i = 0; i < 4; ++i) o[i] = (an[4 * gq + i] + inter_t * aq[4 * gq + i]) * dn;
            v2u w; w.x = cvtpk2(o[0], o[1]); w.y = cvtpk2(o[2], o[3]);
            if (V == 0 || V == 5) asm volatile("global_store_dwordx2 %0, %1, off" :: "v"(op + 8 * gq), "v"(w) : "memory"); else asm volatile("" :: "v"(w)); }
    }
    if (V < 3 && step + 1 < 68) {
        if (wave == 0) { ScGate nxt; sc_gate(c, wr.gi, wr.gf, nxt); cur = nxt; sc_table(c, cur, mprev, (step + 1) & 1); }
        sc_write(c, wr, buf ^ 1); }
    SC_LBAR();
}

template <int V> __device__ __forceinline__ void phase_scan_mfma(Frame& F) {
    unsigned char* ws = F.ws;
    ScCtx c; c.PRJ = (const bf16_t*)(ws + WS_PRJ); c.GATES = (const float*)(ws + WS_GATES); c.lds = F.lds;
    c.lane = F.lane; c.wave = F.wave; c.r = F.lane & 31; c.h = F.lane >> 5;
    c.g = (LAS float*)(F.lds + SC_GS);
    LAS unsigned char* lds = F.lds; const int tid = F.tid;
    if (F.wave >= 4) __builtin_amdgcn_s_setprio(3);
    for (int it0 = F.bx; it0 < 256; it0 += F.G) {
        const int item = (F.G == 256) ? ((it0 & 7) * 32 + (it0 >> 3)) : it0;
        c.vs = item & 3; c.dir = (item >> 2) & 1; c.hh = (item >> 3) & 7; c.b = item >> 6;
        c.HO = (bf16_t*)(ws + (c.dir ? WS_HB : WS_HF));
        c.grow = c.dir ? 63 - c.lane : c.lane; c.sgn = c.dir ? -1 : 1;
        c.okm = 0u;
        if (F.wave >= 4) { const int sb = (F.wave - 4) >> 1, tb = (F.wave - 4) & 1, t = 32 * tb + c.r;
#pragma unroll
            for (int k = 0; k < 16; ++k) { const int sr_ = 32 * sb + 8 * (k >> 2) + 4 * c.h + (k & 3); if (c.sgn * (sr_ - t) <= 0) c.okm |= 1u << k; } }
        __syncthreads();
        for (int i = tid; i < 96 * SC_CP / 16; i += NTHREADS) *(LAS v4u*)(lds + SC_CT + i * 16) = (v4u){0u, 0u, 0u, 0u};
        sf32x16 accC[3];
#pragma unroll
        for (int n = 0; n < 3; ++n)
#pragma unroll
            for (int i = 0; i < 16; ++i) accC[n][i] = 0.f;
        float mprev = 0.f;
        ScStage SA, SB;
        ScGate cur;
        sc_load(c, 0, SA); sc_load(c, 1, SB);
        sc_write(c, SA, 0);
        if (F.wave == 0) { sc_gate(c, SA.gi, SA.gf, cur); sc_table(c, cur, mprev, 0); }
        __syncthreads();
        for (int step = 0; step < 68; step += 2) {
            sc_step<V>(c, step, SA, SB, cur, mprev, accC);
            sc_step<V>(c, step + 1, SB, SA, cur, mprev, accC);
        }
    }
    __builtin_amdgcn_s_setprio(0);
    __syncthreads();
}
namespace att2 {
typedef short bf16x8 __attribute__((ext_vector_type(8)));
typedef short s16x4 __attribute__((ext_vector_type(4)));
constexpr int KP = 272, TP = 136, KBUF = 64 * KP, VBUF = 128 * TP, A2_K = 0, A2_V = 2 * KBUF, A2_BYTES = 2 * KBUF + 3 * VBUF;
constexpr float SCALE = 0.088388347648318440f, THR = 8.f, CL2 = SCALE * 1.4426950408889634f;
constexpr int LDQ = LDA2, LDK = LDKV, LDO = LDA2;
#define A2_MFMA(a, b, c) __builtin_amdgcn_mfma_f32_16x16x32_bf16((a), (b), (c), 0, 0, 0)
struct Stg { v4u k0, k1, v0, v1; };
__device__ __forceinline__ float xmax4(float v) { v = fmaxf(v, __shfl_xor(v, 16)); v = fmaxf(v, __shfl_xor(v, 32)); return v; }
__device__ __forceinline__ float xsum4(float v) { v += __shfl_xor(v, 16); v += __shfl_xor(v, 32); return v; }
__device__ __forceinline__ void tr_write(LAS unsigned char* T, const v4u w, int row, int c0, int lane) {
    const bool hi = (lane >> 3) & 1;
    unsigned r0 = sc_dppu<0x108>(0u, w[0]), r1 = sc_dppu<0x108>(0u, w[1]);
    r0 = sc_dppu<0x118>(r0, w[2]); r1 = sc_dppu<0x118>(r1, w[3]);
    const unsigned a0 = hi ? r0 : w[0], a1 = hi ? r1 : w[1], b0 = hi ? w[2] : r0, b1 = hi ? w[3] : r1;
    LAS unsigned char* p = T + (c0 + (hi ? 4 : 0)) * TP + 2 * (row & ~1);
    *(LAS unsigned*)(p) = pk_lo(a0, b0); *(LAS unsigned*)(p + TP) = pk_hi(a0, b0); *(LAS unsigned*)(p + 2 * TP) = pk_lo(a1, b1); *(LAS unsigned*)(p + 3 * TP) = pk_hi(a1, b1);
}
__device__ __forceinline__ void sload(Stg& s, const bf16_t* Kh, const bf16_t* Vh, int key0, int wave, int lane) {
    const int row = 8 * wave + (lane >> 3), ch = lane & 7;
    const bf16_t* pk = Kh + (size_t)(key0 + row) * LDK + ch * 8; const bf16_t* pv = Vh + (size_t)(key0 + row) * LDK + ch * 8;
    s.k0 = *(const v4u*)pk; s.k1 = *(const v4u*)(pk + 64); s.v0 = *(const v4u*)pv; s.v1 = *(const v4u*)(pv + 64);
}
__device__ __forceinline__ void swrite(const Stg& s, LAS unsigned char* lds, int kbuf, int voff, int wave, int lane) {
    const int row = 8 * wave + (lane >> 3), ch = lane & 7;
    LAS unsigned char* kb = lds + A2_K + kbuf * KBUF; LAS unsigned char* vb = lds + A2_V + voff;
    *(LAS v4u*)(kb + row * KP + ch * 16) = s.k0; *(LAS v4u*)(kb + row * KP + (ch + 8) * 16) = s.k1;
    tr_write(vb, s.v0, row, ch * 8, lane); tr_write(vb, s.v1, row, 64 + ch * 8, lane);
}
__device__ __forceinline__ void qkt(f32x4 (&s)[2][4], const LAS unsigned char* kb, const bf16x8 (&qf)[2][4], int fr, int fq) {
    const LAS unsigned char* rp = kb + fr * KP + fq * 16;
    bf16x8 kf[2][4];
#pragma unroll
    for (int ks = 0; ks < 4; ++ks) kf[0][ks] = *(const LAS bf16x8*)(rp + ks * 64);
#pragma unroll
    for (int kt = 0; kt < 4; ++kt) {
        if (kt + 1 < 4) {
#pragma unroll
            for (int ks = 0; ks < 4; ++ks) kf[(kt + 1) & 1][ks] = *(const LAS bf16x8*)(rp + (kt + 1) * 16 * KP + ks * 64); }
        __builtin_amdgcn_sched_barrier(0);
#pragma unroll
        for (int qb = 0; qb < 2; ++qb) { f32x4 acc = (f32x4){0.f, 0.f, 0.f, 0.f};
#pragma unroll
            for (int ks = 0; ks < 4; ++ks) acc = A2_MFMA(kf[kt & 1][ks], qf[qb][ks], acc);
            s[qb][kt] = acc; }
        __builtin_amdgcn_sched_barrier(0);
    }
}
__device__ __forceinline__ void partial_sm(f32x4 (&s)[2][4], float (&m)[2], float (&al)[2]) {
    float pm[2];
#pragma unroll
    for (int qb = 0; qb < 2; ++qb) { float v = fmaxf(fmaxf(s[qb][0][0], s[qb][0][1]), fmaxf(s[qb][0][2], s[qb][0][3]));
#pragma unroll
        for (int kt = 1; kt < 4; ++kt) v = fmaxf(v, fmaxf(fmaxf(s[qb][kt][0], s[qb][kt][1]), fmaxf(s[qb][kt][2], s[qb][kt][3])));
        pm[qb] = xmax4(v); }
    float mn[2];
    if (__builtin_expect(__all((pm[0] - m[0] <= THR / SCALE) && (pm[1] - m[1] <= THR / SCALE)), 1)) { mn[0] = m[0]; mn[1] = m[1]; al[0] = 1.f; al[1] = 1.f; }
    else {
#pragma unroll
        for (int qb = 0; qb < 2; ++qb) { mn[qb] = fmaxf(m[qb], pm[qb]); al[qb] = __builtin_amdgcn_exp2f((m[qb] - mn[qb]) * CL2); m[qb] = mn[qb]; } }
#pragma unroll
    for (int qb = 0; qb < 2; ++qb) { const float mc = -mn[qb] * CL2;
#pragma unroll
        for (int kt = 0; kt < 4; ++kt)
#pragma unroll
            for (int i = 0; i < 4; ++i) s[qb][kt][i] = fmaf(s[qb][kt][i], CL2, mc);
#pragma unroll
        for (int kt = 0; kt < 2; ++kt)
#pragma unroll
            for (int i = 0; i < 4; ++i) s[qb][kt][i] = __builtin_amdgcn_exp2f(s[qb][kt][i]); }
}
__device__ __forceinline__ void finish_sm(f32x4 (&s)[2][4], const float (&al)[2], float (&l)[2], bf16x8 (&pf)[2][2]) {
#pragma unroll
    for (int qb = 0; qb < 2; ++qb) {
#pragma unroll
        for (int kt = 2; kt < 4; ++kt)
#pragma unroll
            for (int i = 0; i < 4; ++i) s[qb][kt][i] = __builtin_amdgcn_exp2f(s[qb][kt][i]);
        float ps = 0.f;
#pragma unroll
        for (int kt = 0; kt < 4; ++kt) ps += (s[qb][kt][0] + s[qb][kt][1]) + (s[qb][kt][2] + s[qb][kt][3]);
        l[qb] = l[qb] * al[qb] + ps;
#pragma unroll
        for (int u = 0; u < 2; ++u) { const v4u w = (v4u){cvtpk2(s[qb][2 * u][0], s[qb][2 * u][1]), cvtpk2(s[qb][2 * u][2], s[qb][2 * u][3]), cvtpk2(s[qb][2 * u + 1][0], s[qb][2 * u + 1][1]), cvtpk2(s[qb][2 * u + 1][2], s[qb][2 * u + 1][3])};
            pf[qb][u] = __builtin_bit_cast(bf16x8, w); } }
}
__device__ __forceinline__ void pv(f32x4 (&o)[2][8], const LAS unsigned char* vb, const bf16x8 (&pf)[2][2], int fr, int fq) {
    const LAS unsigned char* rp = vb + fr * TP + fq * 8;
    s16x4 lo[2][2], hi[2][2];
#pragma unroll
    for (int u = 0; u < 2; ++u) { lo[0][u] = *(const LAS s16x4*)(rp + u * 64); hi[0][u] = *(const LAS s16x4*)(rp + u * 64 + 32); }
#pragma unroll
    for (int dt = 0; dt < 8; ++dt) {
        if (dt + 1 < 8) {
#pragma unroll
            for (int u = 0; u < 2; ++u) { lo[(dt + 1) & 1][u] = *(const LAS s16x4*)(rp + (dt + 1) * 16 * TP + u * 64); hi[(dt + 1) & 1][u] = *(const LAS s16x4*)(rp + (dt + 1) * 16 * TP + u * 64 + 32); } }
        __builtin_amdgcn_sched_barrier(0);
#pragma unroll
        for (int u = 0; u < 2; ++u) { const bf16x8 vf = __builtin_shufflevector(lo[dt & 1][u], hi[dt & 1][u], 0, 1, 2, 3, 4, 5, 6, 7);
#pragma unroll
            for (int qb = 0; qb < 2; ++qb) o[qb][dt] = A2_MFMA(vf, pf[qb][u], o[qb][dt]); }
        __builtin_amdgcn_sched_barrier(0);
    }
}
__device__ __forceinline__ void resc(f32x4 (&o)[2][8], const float (&al)[2]) {
    if (__any(al[0] < 1.f || al[1] < 1.f)) {
#pragma unroll
        for (int qb = 0; qb < 2; ++qb)
#pragma unroll
            for (int dt = 0; dt < 8; ++dt) o[qb][dt] = o[qb][dt] * al[qb]; }
}
__device__ __forceinline__ void attn_body16(const bf16_t* __restrict__ Qb, const bf16_t* __restrict__ Kh, const bf16_t* __restrict__ Vh, bf16_t* __restrict__ Ob, int seq, LAS unsigned char* lds, int wave, int lane) {
    const int fr = lane & 15, fq = lane >> 4;
    bf16x8 qf[2][4];
#pragma unroll
    for (int qb = 0; qb < 2; ++qb)
#pragma unroll
        for (int ks = 0; ks < 4; ++ks) qf[qb][ks] = *(const bf16x8*)(Qb + (size_t)(wave * 32 + 16 * qb + fr) * LDQ + 32 * ks + 8 * fq);
    f32x4 o[2][8];
#pragma unroll
    for (int qb = 0; qb < 2; ++qb)
#pragma unroll
        for (int dt = 0; dt < 8; ++dt) o[qb][dt] = (f32x4){0.f, 0.f, 0.f, 0.f};
    float m[2] = {-1e30f, -1e30f}, l[2] = {0.f, 0.f}, al[2];
    f32x4 s[2][4]; bf16x8 pf[2][2];
    Stg S; const int NT = seq / 64;
#define A2_SBAR() __builtin_amdgcn_sched_barrier(0)
    const bool late = wave >= 4;
    int vP = 2 * VBUF, vC = 0, vN = VBUF;
    sload(S, Kh, Vh, 0, wave, lane); swrite(S, lds, 0, 0, wave, lane); __syncthreads();
    sload(S, Kh, Vh, 64, wave, lane);
    for (int j = 0; j < NT; ++j) {
        const LAS unsigned char* kb = lds + A2_K + (j & 1) * KBUF;
        if (late && j > 0) { A2_SBAR(); pv(o, lds + A2_V + vP, pf, fr, fq); }
        A2_SBAR(); qkt(s, kb, qf, fr, fq);
        partial_sm(s, m, al); finish_sm(s, al, l, pf); resc(o, al); A2_SBAR();
        if (j + 1 < NT) swrite(S, lds, (j + 1) & 1, vN, wave, lane);
        if (!late) { A2_SBAR(); pv(o, lds + A2_V + vC, pf, fr, fq); }
        __syncthreads();
        if (j + 2 < NT) sload(S, Kh, Vh, (j + 2) * 64, wave, lane);
        { const int t_ = vP; vP = vC; vC = vN; vN = t_; }
    }
    if (late) pv(o, lds + A2_V + vP, pf, fr, fq);
#undef A2_SBAR
#pragma unroll
    for (int qb = 0; qb < 2; ++qb) { const float inv = 1.0f / xsum4(l[qb]);
        bf16_t* op = Ob + (size_t)(wave * 32 + 16 * qb + fr) * LDO + 4 * fq;
#pragma unroll
        for (int dt = 0; dt < 8; ++dt) { const f32x4 v = o[qb][dt] * inv; v2u w; w.x = cvtpk2(v[0], v[1]); w.y = cvtpk2(v[2], v[3]); *(v2u*)(op + 16 * dt) = w; } }
}
}
__device__ __forceinline__ void phase_attn(Frame& F, char* lds_generic) {
    unsigned char* ws = F.ws;
    const bf16_t* Q1 = (const bf16_t*)(ws + WS_Q1); const bf16_t* K1 = (const bf16_t*)(ws + WS_K1); const bf16_t* V1 = (const bf16_t*)(ws + WS_V1); bf16_t* HA = (bf16_t*)(ws + WS_HA);
    const int xcd = F.bx & 7, loc = F.bx >> 3;
    for (int i = 0; ; ++i) {
        int u;
        if (F.G == 256) { const int hg = i * 8 + xcd; if (hg >= 32) break; u = (hg >> 1) * 64 + (hg & 1) * 32 + loc; }
        else { u = i * F.G + F.bx; if (u >= 1024) break; }
        const int g = u >> 6, w = u & 63, b = g >> 2, kvh = g & 3, hq = kvh * 4 + (w >> 4), qb = w & 15;
        const size_t qrow = (size_t)b * RB + qb * 256;
#if !defined(MK_ATTN16)
        att::attn_dense_body<att::bf16>(Q1 + qrow * LDA2 + hq * 128, K1 + (size_t)b * RB * LDKV + kvh * 128, V1 + (size_t)b * RB * LDKV + kvh * 128, HA + qrow * LDA2 + hq * 128, RB, lds_generic);
#else
        att2::attn_body16(Q1 + qrow * LDA2 + hq * 128, K1 + (size_t)b * RB * LDKV + kvh * 128, V1 + (size_t)b * RB * LDKV + kvh * 128, HA + qrow * LDA2 + hq * 128, RB, F.lds, F.wave, F.lane);
#endif
        __syncthreads();
    }
}
#ifndef MK_N_LAUNCHES
#define MK_N_LAUNCHES 1
#endif
constexpr int N_PHASES = 18;
#ifndef MK_DUP
#define MK_DUP 0u
#endif
#define REP(k) for (int rep_ = 0; rep_ < 1 + (int)(((MK_DUP) >> (k)) & 1u); ++rep_)
__global__ void __launch_bounds__(NTHREADS, 2) mega_fwd(Args a) {
    extern __shared__ __attribute__((aligned(16))) unsigned char lds[];
    Frame F;
    F.lds = (LAS unsigned char*)lds; F.MISC = (volatile LAS unsigned*)(F.lds + MISC_OFF);
    F.tid = threadIdx.x; F.lane = F.tid & 63; F.wave = __builtin_amdgcn_readfirstlane(F.tid >> 6);
    F.G = gridDim.x; F.bx = blockIdx.x; F.vcu = (F.G % 8 == 0) ? (F.bx % 8) * (F.G / 8) + F.bx / 8 : F.bx;
    F.ws = a.ws;
    unsigned char* ws = a.ws;
    if (F.tid < 128) F.MISC[F.tid] = 0u;
    __syncthreads();
    const int lo = a.ph_lo, hi = a.ph_hi;
    XcdBarrier bar; bar.bar = (unsigned*)(ws + WS_CTL) + CW_BAR + a.li * XCD_BAR_WORDS; bar.x = 0; bar.st = nullptr;
    if (hi - lo > 1) bar = xcd_barrier_post((unsigned*)(ws + WS_CTL) + CW_BAR + a.li * XCD_BAR_WORDS, F.MISC + 8);
#define IN(k) (lo <= (k) && (k) < hi)
#define SEAM(k) do { if (IN(k) && IN((k) + 1)) xcd_barrier(bar); } while (0)
    bf16_t* HA = (bf16_t*)(ws + WS_HA); bf16_t* Yb = (bf16_t*)(ws + WS_Y); bf16_t* PRJ = (bf16_t*)(ws + WS_PRJ); bf16_t* Hh = (bf16_t*)(ws + WS_PRJ);
    const bf16_t* WIN = (const bf16_t*)(ws + WS_WIN); const bf16_t* WMO = (const bf16_t*)(ws + WS_WMO); const bf16_t* WQKV = (const bf16_t*)(ws + WS_WQKV); const bf16_t* WAO = (const bf16_t*)(ws + WS_WAO);
    const bf16_t* WFI = (const bf16_t*)(ws + WS_WFI); const bf16_t* WFO = (const bf16_t*)(ws + WS_WFO);

    unsigned* const dctr = (unsigned*)(ws + WS_CTL) + 64;
    if (IN(0)) REP(0) { if (rep_) xcd_barrier(bar); phase_prep(F, a, dctr); } SEAM(0);
    if (IN(1)) REP(1) { if (rep_) xcd_barrier(bar); const RowCfg c{1, 0, 0, 1, 1, 0, 0, nullptr, 0, 0, 1, a.in[IN_GMIXPRE]}; phase_rows(F, a, c); } SEAM(1);
    constexpr int G2 = 238, G7 = 250;
    if (IN(2)) REP(2) { if (rep_) xcd_barrier(bar);
        const int gg = (F.G == 256) ? G2 : F.G;
        if (F.bx < gg) { pg8::Gemm g{HA, WIN, R, MIN_PAD, DM, LDA2, LDW}; pg8::Order S; S.init(68, 17, gg, F.bx, 0, 32); S.pn24 = 1; S.ctx_split(1, 16, 8);
            pg8::EpiInProj E{PRJ, (float*)(ws + WS_GATES), a.in[IN_BGATE]};
            pg8::gemm_phase<pg8::EpiInProj, pg8::Order, true, true>(F.lds, g, S, E); }
        mod_drain(F, a, dctr + 64, 64, 384); conv_items(F, a, dctr + 128, CV_A0, CV_B0, 2); } SEAM(2);
    if (IN(3)) REP(3) { if (rep_) xcd_barrier(bar);
#if defined(MK_SCAN_NAIVE)
        phase_scan_naive(F, a);
#else
#if defined(MK_SCANV)
        if (rep_ == 0) phase_scan_mfma<MK_SCANV>(F); else phase_scan_mfma<0>(F);
#else
        phase_scan_mfma<0>(F);
#endif
#endif
    } SEAM(3);
    bf16_t* HA2 = (bf16_t*)(ws + WS_PRJ);
    if (IN(4)) REP(4) { if (rep_) xcd_barrier(bar); phase_headnorm_ctx(F, a, HA2, PRJ_LD);
        pg8::Gemm g{HA, WIN + (size_t)4096 * LDW, R, DM, DM, LDA2, LDW}; pg8::Order S; S.init(64, 8, F.G, F.bx, 1, 32);
        pg8::EpiHeadNorm E{(const bf16_t*)(ws + WS_HF), (const bf16_t*)(ws + WS_HB), HA2, PRJ_LD, a.in[IN_GHEAD], (LAS float*)(F.lds + 131072)};
        pg8::gemm_phase<pg8::EpiHeadNorm, pg8::Order, true, true>(F.lds, g, S, E); } SEAM(4);
    if (IN(5)) REP(5) { if (rep_) xcd_barrier(bar); pg8::Gemm g{HA2, WMO, R, DM, DM, PRJ_LD, LDW}; pg8::Order S; S.init(64, 8, F.G, F.bx, 1, 32); S.ctx_split(4, 0, 8);
        pg8::EpiPlain E{Yb, LDA2, (bf16_t*)(ws + WS_YS)};
        pg8::gemm_phase<pg8::EpiPlain, pg8::Order, true, true>(F.lds, g, S, E); } SEAM(5);
    if (IN(6)) REP(6) { if (rep_) xcd_barrier(bar); const RowCfg c{1, 1, 1, 1, 1, 0, 2, a.in[IN_GMIXPOST], 0, 3, 4, a.in[IN_GFFNPRE]}; phase_rows(F, a, c); } SEAM(6);
    if (IN(7)) REP(7) { if (rep_) xcd_barrier(bar);
        const int gg = (F.G == 256) ? G7 : F.G;
        if (F.bx < gg) { pg8::Gemm g{HA, WFI, R, 2 * FF, DM, LDA2, LDW}; pg8::Order S; S.init(68, 44, gg, F.bx, 0, 32);
            pg8::EpiSwiglu E{Hh, LDF};
            pg8::gemm_phase<pg8::EpiSwiglu, pg8::Order, true, true>(F.lds, g, S, E); }
        conv_items(F, a, dctr + 192, CV_B0, CV_END, 2); } SEAM(7);
    if (IN(8)) REP(8) { if (rep_) xcd_barrier(bar); pg8::Gemm g{Hh, WFO, R, DM, FF, LDF, LDWF}; pg8::Order S; S.init(64, 8, F.G, F.bx, 1, 88); S.ctx_split(4, 0, 8);
        pg8::EpiPlain E{Yb, LDA2, (bf16_t*)(ws + WS_YS)};
        pg8::gemm_phase<pg8::EpiPlain, pg8::Order, true, true>(F.lds, g, S, E); } SEAM(8);
    if (IN(9)) REP(9) { if (rep_) xcd_barrier(bar); const RowCfg c{0, 1, 1, 1, 1, 0, 5, a.in[IN_GFFNPOST], 1, 0, 1, a.in[IN_GMIXPRE] + DM}; phase_rows(F, a, c); } SEAM(9);
    if (IN(10)) REP(10) { if (rep_) xcd_barrier(bar); pg8::Gemm g{HA, WQKV, R, QKV_COLS, DM, LDA2, LDW}; pg8::Order S; S.init(64, 12, F.G, F.bx, 1, 32); S.ctx_split(8, 8, 4);
        pg8::EpiQkv E{(bf16_t*)(ws + WS_Q1), (bf16_t*)(ws + WS_K1), (bf16_t*)(ws + WS_V1), (bf16_t*)(ws + WS_QS), a.in[IN_GQ], a.in[IN_GK], (const float*)(ws + WS_ROPE), (LAS float*)(F.lds + 131072)};
        pg8::gemm_phase<pg8::EpiQkv, pg8::Order, true, true>(F.lds, g, S, E); } SEAM(10);
    if (IN(11)) REP(11) { if (rep_) xcd_barrier(bar); phase_qknorm(F, a); } SEAM(11);
    if (IN(12)) REP(12) { if (rep_) xcd_barrier(bar); phase_attn(F, (char*)lds); } SEAM(12);
    if (IN(13)) REP(13) { if (rep_) xcd_barrier(bar); pg8::Gemm g{HA, WAO, R, DM, DM, LDA2, LDW}; pg8::Order S; S.init(64, 8, F.G, F.bx, 1, 32);
        pg8::EpiPlain E{Yb, LDA2, (bf16_t*)(ws + WS_YS)};
        pg8::gemm_phase<pg8::EpiPlain, pg8::Order, true, true>(F.lds, g, S, E); } SEAM(13);
    if (IN(14)) REP(14) { if (rep_) xcd_barrier(bar); const RowCfg c{0, 1, 1, 1, 0, 1, 2, a.in[IN_GMIXPOST] + DM, 1, 3, 4, a.in[IN_GFFNPRE] + DM}; phase_rows(F, a, c); } SEAM(14);
    if (IN(15)) REP(15) { if (rep_) xcd_barrier(bar); pg8::Gemm g{HA, WFI + (size_t)2 * FF * LDW, R, 2 * FF, DM, LDA2, LDW}; pg8::Order S; S.init(64, 44, F.G, F.bx, 1, 32);
        pg8::EpiSwiglu E{Hh, LDF};
        pg8::gemm_phase<pg8::EpiSwiglu, pg8::Order, true, true>(F.lds, g, S, E); } SEAM(15);
    if (IN(16)) REP(16) { if (rep_) xcd_barrier(bar); pg8::Gemm g{Hh, WFO + (size_t)DM * LDWF, R, DM, FF, LDF, LDWF}; pg8::Order S; S.init(64, 8, F.G, F.bx, 1, 88);
        pg8::EpiPlain E{Yb, LDA2, (bf16_t*)(ws + WS_YS)};
        pg8::gemm_phase<pg8::EpiPlain, pg8::Order, true, true>(F.lds, g, S, E); } SEAM(16);
    if (IN(17)) REP(17) { if (rep_) xcd_barrier(bar); const RowCfg c{0, 1, 2, 0, 0, 1, 5, a.in[IN_GFFNPOST] + DM, 0, 0, 0, nullptr}; phase_rows(F, a, c); }
#undef IN
#undef SEAM
}

extern "C" void kernel_launch(void* const* d_in, const int* in_sizes, int n_in, void* d_out, int out_size, void* d_ws, size_t ws_size, hipStream_t stream) {
    static int grid = 0;
    if (grid == 0) {
        if (n_in != 20 || out_size != BATCH * SEQ * DM || ws_size < WS_END) { fprintf(stderr, "kernel_launch: unexpected shapes: n_in %d out %d ws %zu (need %zu)\n", n_in, out_size, ws_size, (size_t)WS_END); grid = -1; return; }
        int dev = 0, cus = 0, per_cu = 0;
        if (hipGetDevice(&dev) != hipSuccess || hipDeviceGetAttribute(&cus, hipDeviceAttributeMultiprocessorCount, dev) != hipSuccess) { grid = -1; return; }
        if (hipFuncSetAttribute((const void*)mega_fwd, hipFuncAttributeMaxDynamicSharedMemorySize, LDS_BYTES) != hipSuccess) { fprintf(stderr, "kernel_launch: hipFuncSetAttribute failed\n"); grid = -1; return; }
        if (hipOccupancyMaxActiveBlocksPerMultiprocessor(&per_cu, (const void*)mega_fwd, NTHREADS, LDS_BYTES) != hipSuccess || per_cu < 1) { fprintf(stderr, "kernel_launch: occupancy query says %d\n", per_cu); }
        (void)hipGetLastError();
        grid = cus;
    }
    if (grid < 0) return;
    (void)hipMemsetAsync((char*)d_ws + WS_CTL, 0, CTL_ZERO_BYTES, stream);
    Args a{};
    for (int i = 0; i < 20; ++i) a.in[i] = (const float*)d_in[i];
    a.out = (float*)d_out; a.ws = (unsigned char*)d_ws; a.pad = 0;
#if MK_N_LAUNCHES == 1
    a.ph_lo = 0; a.ph_hi = N_PHASES; a.li = 0;
    hipLaunchKernelGGL(mega_fwd, dim3(grid), dim3(NTHREADS), LDS_BYTES, stream, a);
#else
    for (int p = 0; p < N_PHASES; ++p) { a.ph_lo = p; a.ph_hi = p + 1; a.li = 0;
        hipLaunchKernelGGL(mega_fwd, dim3(grid), dim3(NTHREADS), LDS_BYTES, stream, a); }
#endif
    const hipError_t le = hipPeekAtLastError();
    if (le != hipSuccess) fprintf(stderr, "kernel_launch: launch failed: %s\n", hipGetErrorName(le));
}
```
